# Optimizing an MI355X kernel written in HIP

```python
import math
import jax, jax.numpy as jnp
from jax import lax
import numpy as np

D_MODEL = 1024
BATCH = 8
SEQ = 2048
DEPTH = 1

SSM_HEADS = 8
SSM_HEAD_DIM = 64
D_SSM = SSM_HEADS * SSM_HEAD_DIM
SSM_GROUPS = 2
D_STATE = 128
CONV_WIDTH = 4
CHUNK = 128
D_CONV = D_SSM + 2 * SSM_GROUPS * D_STATE
ATTN_HEADS = 8
KV_HEADS = 2
HEAD_DIM = 64
D_ATTN = ATTN_HEADS * HEAD_DIM
D_KV = KV_HEADS * HEAD_DIM
WINDOW = 128
D_MIX = D_SSM + D_ATTN
D_IN_PROJ = D_SSM + D_CONV + SSM_HEADS + D_ATTN + 2 * D_KV
D_FF = -(-8 * D_MODEL // (3 * 256)) * 256
EPS = 1e-5

kernel_name = "hymba_ssd_swa_sink_hybrid"


def rms_norm(x, w):
    xf = x.astype(jnp.float32)
    y = xf * lax.rsqrt(jnp.mean(xf * xf, axis=-1, keepdims=True) + EPS)
    return (y * w.astype(jnp.float32)).astype(x.dtype)


def causal_depthwise_conv(u, w, b):
    k_width, ch = w.shape
    y = lax.conv_general_dilated(
        u, w[:, None, :].astype(u.dtype), window_strides=(1,),
        padding=[(k_width - 1, 0)], dimension_numbers=("NWC", "WIO", "NWC"),
        feature_group_count=ch)
    return y + b.astype(u.dtype)


def ssd_chunked(x, dt, a, b_mat, c_mat):
    bsz, seq, n_h, p = x.shape
    n_g, n_s = b_mat.shape[2], b_mat.shape[3]
    r = n_h // n_g
    nc = seq // CHUNK
    xdt = (x.astype(jnp.float32) * dt[..., None]).reshape(bsz, nc, CHUNK, n_g, r, p)
    bc = b_mat.astype(jnp.float32).reshape(bsz, nc, CHUNK, n_g, n_s)
    cc = c_mat.astype(jnp.float32).reshape(bsz, nc, CHUNK, n_g, n_s)
    d_a = (dt * a).reshape(bsz, nc, CHUNK, n_g, r).transpose(0, 3, 4, 1, 2)
    a_cum = jnp.cumsum(d_a, axis=-1)
    causal = jnp.tril(jnp.ones((CHUNK, CHUNK), dtype=bool))
    seg = a_cum[..., :, None] - a_cum[..., None, :]
    decay_in = jnp.exp(jnp.where(causal, seg, -jnp.inf))
    cb = jnp.einsum("bctgn,bcsgn->bgcts", cc, bc)
    y_diag = jnp.einsum("bgcts,bgrcts,bcsgrp->bctgrp", cb, decay_in, xdt)
    decay_to_end = jnp.exp(a_cum[..., -1:] - a_cum)
    chunk_states = jnp.einsum("bctgn,bgrct,bctgrp->bcgrpn", bc, decay_to_end, xdt)
    chunk_decay = jnp.exp(a_cum[..., -1])

    def step(h, inp):
        s_c, d_c = inp
        return h * d_c[..., None, None] + s_c, h

    h0 = jnp.zeros((bsz, n_g, r, p, n_s), jnp.float32)
    _, prev_states = lax.scan(step, h0, (jnp.moveaxis(chunk_states, 1, 0),
                                         jnp.moveaxis(chunk_decay, 3, 0)))
    y_off = jnp.einsum("bctgn,cbgrpn,bgrct->bctgrp", cc, prev_states, jnp.exp(a_cum))
    return (y_diag + y_off).reshape(bsz, seq, n_h, p)


def sliding_window_attention_with_sinks(q, k, v, sinks):
    bsz, seq, n_q, d = q.shape
    n_kv = k.shape[2]
    r = n_q // n_kv
    nb = seq // WINDOW
    qb = q.reshape(bsz, nb, WINDOW, n_kv, r, d)

    def with_prev(t):
        tb = t.reshape(bsz, nb, WINDOW, n_kv, d)
        prev = jnp.pad(tb[:, :-1], ((0, 0), (1, 0), (0, 0), (0, 0), (0, 0)))
        return jnp.concatenate([prev, tb], axis=2)

    kb, vb = with_prev(k), with_prev(v)
    scores = jnp.einsum("bnqhrd,bnkhd->bnhrqk", qb, kb).astype(jnp.float32) * (d ** -0.5)
    q_pos = jnp.arange(WINDOW)[:, None] + WINDOW
    k_pos = jnp.arange(2 * WINDOW)[None, :]
    band = (k_pos <= q_pos) & (k_pos > q_pos - WINDOW)
    k_global = (jnp.arange(nb) * WINDOW - WINDOW)[:, None] + k_pos
    mask = band[None] & (k_global >= 0)[:, None, :]
    scores = jnp.where(mask[None, :, None, None], scores, -jnp.inf)
    sink = sinks.astype(jnp.float32).reshape(n_kv, r)[None, None, :, :, None, None]
    m = jnp.maximum(jnp.max(scores, axis=-1, keepdims=True), sink)
    p = jnp.exp(scores - m)
    probs = p / (jnp.sum(p, axis=-1, keepdims=True) + jnp.exp(sink - m))
    out = jnp.einsum("bnhrqk,bnkhd->bnqhrd", probs.astype(v.dtype), vb)
    return out.reshape(bsz, seq, n_q * d)


def hybrid_layer(x, norm_mix_w, w_in, conv_w, conv_b, dt_bias, a_log, d_skip,
                 ssm_norm_w, attn_sinks, w_out, norm_ffn_w, w_gate, w_up, w_down):
    bsz, seq, _ = x.shape
    h = rms_norm(x, norm_mix_w)
    proj = h @ w_in
    s0 = D_SSM
    s1 = s0 + D_CONV
    s2 = s1 + SSM_HEADS
    s3 = s2 + D_ATTN
    s4 = s3 + D_KV
    z, xbc, dt_raw, q, k, v = jnp.split(proj, [s0, s1, s2, s3, s4], axis=-1)

    xbc = jax.nn.silu(causal_depthwise_conv(xbc, conv_w, conv_b))
    xs, bm, cm = jnp.split(xbc, [D_SSM, D_SSM + SSM_GROUPS * D_STATE], axis=-1)
    xs = xs.reshape(bsz, seq, SSM_HEADS, SSM_HEAD_DIM)
    bm = bm.reshape(bsz, seq, SSM_GROUPS, D_STATE)
    cm = cm.reshape(bsz, seq, SSM_GROUPS, D_STATE)
    dt = jax.nn.softplus(dt_raw.astype(jnp.float32) + dt_bias.astype(jnp.float32))
    a = -jnp.exp(a_log.astype(jnp.float32))
    y = ssd_chunked(xs, dt, a, bm, cm) + d_skip.astype(jnp.float32)[:, None] * xs.astype(jnp.float32)
    y = y.reshape(bsz, seq, D_SSM) * jax.nn.silu(z.astype(jnp.float32))
    y_ssm = rms_norm(y.reshape(bsz, seq, SSM_GROUPS, D_SSM // SSM_GROUPS),
                     ssm_norm_w.reshape(SSM_GROUPS, D_SSM // SSM_GROUPS)).reshape(bsz, seq, D_SSM)

    y_attn = sliding_window_attention_with_sinks(
        q.reshape(bsz, seq, ATTN_HEADS, HEAD_DIM),
        k.reshape(bsz, seq, KV_HEADS, HEAD_DIM),
        v.reshape(bsz, seq, KV_HEADS, HEAD_DIM), attn_sinks)

    mixed = jnp.concatenate([y_ssm.astype(x.dtype), y_attn.astype(x.dtype)], axis=-1) @ w_out
    x = x + mixed

    h = rms_norm(x, norm_ffn_w)
    x = x + (jax.nn.silu(h @ w_gate) * (h @ w_up)) @ w_down
    return x


def setup_inputs(seed: int = 0) -> dict:
    key = jax.random.key(seed)
    ks = jax.random.split(key, 20)
    f32 = jnp.float32

    def normal(k, shape, scale):
        return jax.random.normal(k, shape, f32) * scale

    x = jax.random.normal(ks[0], (BATCH, SEQ, D_MODEL), f32)
    norm_mix_w = 1.0 + normal(ks[1], (DEPTH, D_MODEL), 0.02)
    w_in = normal(ks[2], (DEPTH, D_MODEL, D_IN_PROJ), D_MODEL ** -0.5)
    conv_w = normal(ks[3], (DEPTH, CONV_WIDTH, D_CONV), CONV_WIDTH ** -0.5)
    conv_b = normal(ks[4], (DEPTH, D_CONV), 0.02)
    u = jax.random.uniform(ks[5], (DEPTH, SSM_HEADS), f32)
    dt0 = jnp.exp(u * (math.log(0.1) - math.log(0.001)) + math.log(0.001))
    dt_bias = dt0 + jnp.log(-jnp.expm1(-dt0))
    a_log = jnp.log(jax.random.uniform(ks[6], (DEPTH, SSM_HEADS), f32, 1.0, 16.0))
    d_skip = 1.0 + normal(ks[7], (DEPTH, SSM_HEADS), 0.02)
    ssm_norm_w = 1.0 + normal(ks[8], (DEPTH, D_SSM), 0.02)
    attn_sinks = normal(ks[9], (DEPTH, ATTN_HEADS), 0.5)
    w_out = normal(ks[10], (DEPTH, D_MIX, D_MODEL), D_MIX ** -0.5)
    norm_ffn_w = 1.0 + normal(ks[11], (DEPTH, D_MODEL), 0.02)
    w_gate = normal(ks[12], (DEPTH, D_MODEL, D_FF), D_MODEL ** -0.5)
    w_up = normal(ks[13], (DEPTH, D_MODEL, D_FF), D_MODEL ** -0.5)
    w_down = normal(ks[14], (DEPTH, D_FF, D_MODEL), D_FF ** -0.5)
    norm_final_w = 1.0 + normal(ks[15], (D_MODEL,), 0.02)
    return {"x": x, "norm_mix_w": norm_mix_w, "w_in": w_in, "conv_w": conv_w,
            "conv_b": conv_b, "dt_bias": dt_bias, "a_log": a_log, "d_skip": d_skip,
            "ssm_norm_w": ssm_norm_w, "attn_sinks": attn_sinks, "w_out": w_out,
            "norm_ffn_w": norm_ffn_w, "w_gate": w_gate, "w_up": w_up,
            "w_down": w_down, "norm_final_w": norm_final_w}


def reference(x, norm_mix_w, w_in, conv_w, conv_b, dt_bias, a_log, d_skip,
              ssm_norm_w, attn_sinks, w_out, norm_ffn_w, w_gate, w_up, w_down,
              norm_final_w):
    for i in range(DEPTH):
        x = hybrid_layer(x, norm_mix_w[i], w_in[i], conv_w[i], conv_b[i], dt_bias[i],
                         a_log[i], d_skip[i], ssm_norm_w[i], attn_sinks[i], w_out[i],
                         norm_ffn_w[i], w_gate[i], w_up[i], w_down[i])
    return rms_norm(x, norm_final_w)
```

```cpp
#include <hip/hip_runtime.h>
#include <cstdint>
#include <cstdio>

constexpr int D_MODEL = 1024, BATCH = 8, SEQ = 2048, M = BATCH * SEQ;
constexpr int D_SSM = 512, D_STATE = 128, D_CONV = 1024, D_ATTN = 512, D_KV = 128;
constexpr int D_IN = 2312, D_FF = 2816;
constexpr int S0 = 512, S1 = 1536, S2 = 1544, S3 = 2056, S4 = 2184;
constexpr float EPS = 1e-5f;

__device__ __forceinline__ float silu_f(float v) { return v / (1.f + __expf(-v)); }
__device__ __forceinline__ float wave_sum(float v) {
#pragma unroll
    for (int o = 1; o < 64; o <<= 1) v += __shfl_xor(v, o);
    return v;
}

__global__ void __launch_bounds__(256) k_rmsnorm(const float* x, const float* __restrict__ w, float* out, int rows) {
    const int lane = threadIdx.x & 63, gw = (blockIdx.x * 256 + threadIdx.x) >> 6, nw = (gridDim.x * 256) >> 6;
    for (int r = gw; r < rows; r += nw) {
        const float4* xr = (const float4*)(x + (size_t)r * D_MODEL);
        float4 v[4]; float s = 0.f;
#pragma unroll
        for (int j = 0; j < 4; ++j) { v[j] = xr[lane + 64 * j]; s += v[j].x * v[j].x + v[j].y * v[j].y + v[j].z * v[j].z + v[j].w * v[j].w; }
        const float rs = rsqrtf(wave_sum(s) * (1.f / D_MODEL) + EPS);
        float4* o = (float4*)(out + (size_t)r * D_MODEL);
#pragma unroll
        for (int j = 0; j < 4; ++j) { const float4 ww = ((const float4*)w)[lane + 64 * j];
            o[lane + 64 * j] = make_float4(v[j].x * rs * ww.x, v[j].y * rs * ww.y, v[j].z * rs * ww.z, v[j].w * rs * ww.w); }
    }
}

template <int MODE>
__global__ void __launch_bounds__(256) k_gemm(const float* __restrict__ A, int lda, const float* __restrict__ W, const float* __restrict__ W2, int ldw,
                                              float* C, int ldc, const float* R, int ldr, int Mr, int N, int K) {
    __shared__ float As[16][65];
    __shared__ float Bs[16][65];
    __shared__ float Bs2[16][65];
    const int tx = threadIdx.x & 15, ty = threadIdx.x >> 4;
    const int m0 = blockIdx.y * 64, n0 = blockIdx.x * 64;
    float acc[4][4], acc2[4][4];
#pragma unroll
    for (int i = 0; i < 4; ++i)
#pragma unroll
        for (int j = 0; j < 4; ++j) { acc[i][j] = 0.f; acc2[i][j] = 0.f; }
    for (int k0 = 0; k0 < K; k0 += 16) {
#pragma unroll
        for (int i = 0; i < 4; ++i) { const int idx = threadIdx.x + 256 * i, r = idx >> 4, c = idx & 15; As[c][r] = A[(size_t)(m0 + r) * lda + k0 + c]; }
#pragma unroll
        for (int i = 0; i < 4; ++i) { const int idx = threadIdx.x + 256 * i, r = idx >> 6, c = idx & 63; const int n = n0 + c;
            Bs[r][c] = n < N ? W[(size_t)(k0 + r) * ldw + n] : 0.f;
            if (MODE == 2) Bs2[r][c] = n < N ? W2[(size_t)(k0 + r) * ldw + n] : 0.f; }
        __syncthreads();
#pragma unroll
        for (int kk = 0; kk < 16; ++kk) {
            float a[4], b[4], b2[4];
#pragma unroll
            for (int i = 0; i < 4; ++i) { a[i] = As[kk][ty * 4 + i]; b[i] = Bs[kk][tx * 4 + i]; if (MODE == 2) b2[i] = Bs2[kk][tx * 4 + i]; }
#pragma unroll
            for (int i = 0; i < 4; ++i)
#pragma unroll
                for (int j = 0; j < 4; ++j) { acc[i][j] += a[i] * b[j]; if (MODE == 2) acc2[i][j] += a[i] * b2[j]; }
        }
        __syncthreads();
    }
#pragma unroll
    for (int i = 0; i < 4; ++i)
#pragma unroll
        for (int j = 0; j < 4; ++j) { const int r = m0 + ty * 4 + i, n = n0 + tx * 4 + j; if (n < N) {
            float v = acc[i][j];
            if (MODE == 1) v += R[(size_t)r * ldr + n];
            if (MODE == 2) v = silu_f(v) * acc2[i][j];
            C[(size_t)r * ldc + n] = v; } }
}

__global__ void __launch_bounds__(256) k_conv(const float* __restrict__ proj, const float* __restrict__ cw, const float* __restrict__ cb, float* xc) {
    const size_t idx = (size_t)blockIdx.x * 256 + threadIdx.x;
    if (idx >= (size_t)M * D_CONV) return;
    const int c = idx % D_CONV; const int m = idx / D_CONV; const int t = m % SEQ;
    float a = cb[c];
#pragma unroll
    for (int k = 0; k < 4; ++k) { const int tt = t - 3 + k; if (tt >= 0) a += cw[k * D_CONV + c] * proj[(size_t)(m - 3 + k) * D_IN + S0 + c]; }
    xc[idx] = silu_f(a);
}

__global__ void __launch_bounds__(64) k_ssd(const float* __restrict__ proj, const float* __restrict__ xc, const float* __restrict__ dt_bias, const float* __restrict__ a_log,
                                            const float* __restrict__ d_skip, float* y) {
    const int b = blockIdx.x >> 3, h = blockIdx.x & 7, g = h >> 2, p = threadIdx.x;
    float st[128];
#pragma unroll
    for (int n = 0; n < 128; ++n) st[n] = 0.f;
    const float a = -__expf(a_log[h]), dsk = d_skip[h], dtb = dt_bias[h];
    for (int t = 0; t < SEQ; ++t) {
        const size_t m = (size_t)b * SEQ + t;
        const float raw = proj[m * D_IN + S1 + h] + dtb;
        const float dt = raw > 20.f ? raw : log1pf(__expf(raw));
        const float dec = __expf(dt * a);
        const float xv = xc[m * D_CONV + h * 64 + p];
        const float xdt = xv * dt;
        const float* Bp = xc + m * D_CONV + 512 + g * 128;
        const float* Cp = xc + m * D_CONV + 768 + g * 128;
        float acc = 0.f;
#pragma unroll
        for (int n = 0; n < 128; ++n) { st[n] = st[n] * dec + xdt * Bp[n]; acc += Cp[n] * st[n]; }
        y[m * D_SSM + h * 64 + p] = acc + dsk * xv;
    }
}

__global__ void __launch_bounds__(256) k_gatenorm(const float* __restrict__ y, const float* __restrict__ proj, const float* __restrict__ nw, float* ymix) {
    const int lane = threadIdx.x & 63, gw = (blockIdx.x * 256 + threadIdx.x) >> 6;
    if (gw >= M * 2) return;
    const int m = gw >> 1, g = gw & 1;
    float v[4]; float s = 0.f;
#pragma unroll
    for (int j = 0; j < 4; ++j) { const int c = g * 256 + lane * 4 + j; const float z = proj[(size_t)m * D_IN + c]; v[j] = y[(size_t)m * D_SSM + c] * silu_f(z); s += v[j] * v[j]; }
    const float rs = rsqrtf(wave_sum(s) * (1.f / 256.f) + EPS);
#pragma unroll
    for (int j = 0; j < 4; ++j) { const int c = g * 256 + lane * 4 + j; ymix[(size_t)m * 1024 + c] = v[j] * rs * nw[c]; }
}

__global__ void __launch_bounds__(64) k_attn(const float* __restrict__ proj, const float* __restrict__ sinks, float* ymix) {
    const int idx = blockIdx.x * 64 + threadIdx.x;
    const int hq = idx / M, m = idx % M, t = m % SEQ, kvh = hq >> 2;
    float q[64], acc[64];
#pragma unroll
    for (int d = 0; d < 64; ++d) { q[d] = proj[(size_t)m * D_IN + S2 + hq * 64 + d]; acc[d] = 0.f; }
    float mx = sinks[hq], l = 1.f;
    const int klo = t - 127 < 0 ? 0 : t - 127;
    for (int kt = klo; kt <= t; ++kt) {
        const float* kp = proj + (size_t)(m - t + kt) * D_IN + S3 + kvh * 64;
        const float* vp = proj + (size_t)(m - t + kt) * D_IN + S4 + kvh * 64;
        float s = 0.f;
#pragma unroll
        for (int d = 0; d < 64; ++d) s += q[d] * kp[d];
        s *= 0.125f;
        const float mn = fmaxf(mx, s), sc = __expf(mx - mn), pe = __expf(s - mn);
        l = l * sc + pe; mx = mn;
#pragma unroll
        for (int d = 0; d < 64; ++d) acc[d] = acc[d] * sc + pe * vp[d];
    }
    const float inv = 1.f / l;
#pragma unroll
    for (int d = 0; d < 64; ++d) ymix[(size_t)m * 1024 + 512 + hq * 64 + d] = acc[d] * inv;
}

extern "C" void kernel_launch(void* const* d_in, const int* in_sizes, int n_in, void* d_out, int out_size, void* d_ws, size_t ws_size, hipStream_t stream) {
    const float* x = (const float*)d_in[0]; const float* norm_mix_w = (const float*)d_in[1]; const float* w_in = (const float*)d_in[2];
    const float* conv_w = (const float*)d_in[3]; const float* conv_b = (const float*)d_in[4]; const float* dt_bias = (const float*)d_in[5];
    const float* a_log = (const float*)d_in[6]; const float* d_skip = (const float*)d_in[7]; const float* ssm_norm_w = (const float*)d_in[8];
    const float* sinks = (const float*)d_in[9]; const float* w_out = (const float*)d_in[10]; const float* norm_ffn_w = (const float*)d_in[11];
    const float* w_gate = (const float*)d_in[12]; const float* w_up = (const float*)d_in[13]; const float* w_down = (const float*)d_in[14];
    const float* norm_final_w = (const float*)d_in[15];
    float* out = (float*)d_out; char* ws = (char*)d_ws;
    const size_t MB = 1u << 20;
    float* proj = (float*)ws;
    float* xc = (float*)(ws + 152 * MB);
    float* yssd = (float*)(ws + 216 * MB);
    float* hbuf = out;
    k_rmsnorm<<<1024, 256, 0, stream>>>(x, norm_mix_w, hbuf, M);
    k_gemm<0><<<dim3((D_IN + 63) / 64, M / 64), 256, 0, stream>>>(hbuf, 1024, w_in, nullptr, D_IN, proj, D_IN, nullptr, 0, M, D_IN, 1024);
    k_conv<<<(M * D_CONV) / 256, 256, 0, stream>>>(proj, conv_w, conv_b, xc);
    k_ssd<<<64, 64, 0, stream>>>(proj, xc, dt_bias, a_log, d_skip, yssd);
    float* ymix = out;
    k_gatenorm<<<(M * 2 * 64) / 256, 256, 0, stream>>>(yssd, proj, ssm_norm_w, ymix);
    k_attn<<<(M * 8) / 64, 64, 0, stream>>>(proj, sinks, ymix);
    float* x2 = xc;
    k_gemm<1><<<dim3(1024 / 64, M / 64), 256, 0, stream>>>(ymix, 1024, w_out, nullptr, 1024, x2, 1024, x, 1024, M, 1024, 1024);
    float* h2 = (float*)(ws + 0);
    k_rmsnorm<<<1024, 256, 0, stream>>>(x2, norm_ffn_w, h2, M);
    float* act = (float*)(ws + 64 * MB);
    for (int half = 0; half < 2; ++half) {
        const size_t r0 = (size_t)half * 8192;
        k_gemm<2><<<dim3(D_FF / 64, 8192 / 64), 256, 0, stream>>>(h2 + r0 * 1024, 1024, w_gate, w_up, D_FF, act, D_FF, nullptr, 0, 8192, D_FF, 1024);
        k_gemm<1><<<dim3(1024 / 64, 8192 / 64), 256, 0, stream>>>(act, D_FF, w_down, nullptr, 1024, out + r0 * 1024, 1024, x2 + r0 * 1024, 1024, 8192, 1024, D_FF);
    }
    k_rmsnorm<<<1024, 256, 0, stream>>>(out, norm_final_w, out, M);
}
```

```cpp
#include <hip/hip_runtime.h>
#include <hip/hip_cooperative_groups.h>
#include <cstdio>
#include <cstdint>
namespace cg = cooperative_groups;
namespace pg8 {
#define PG8_LAS __attribute__((address_space(3)))
typedef unsigned short bf16_t;
typedef short bf16x8 __attribute__((ext_vector_type(8)));
typedef float f32x4 __attribute__((ext_vector_type(4)));
typedef unsigned u32x4 __attribute__((ext_vector_type(4)));
constexpr int BM = 256, BK = 64, HALF = 128, HTB = HALF * BK * 2  , STAGE_BYTES = 8 * HTB, NXCD = 8, WGM = 8;

__host__ __device__ __forceinline__ int lds_byte(int r, int c) { const int st = (r >> 4) * 2 + (c >> 5), rr = r & 15, cc = c & 31, ob = rr * 64 + cc * 2; return st * 1024 + (ob ^ (((ob >> 9) & 1) << 5)); }
__host__ __device__ __forceinline__ void stage_rc(int b, int& R, int& C) { const int st = b / 1024, sb = b % 1024, swz = sb ^ (((sb >> 9) & 1) << 5); R = (st >> 1) * 16 + swz / 64; C = (st & 1) * 32 + (swz % 64) / 2; }
__host__ __device__ __forceinline__ int perm32(int rho) { const int n = rho >> 4, i = rho & 15; return 8 * (i >> 2) + 4 * n + (i & 3); }

struct Unit { int pm, pn; };
struct Gemm { const bf16_t* A; const bf16_t* Bt; int M, N, K; };

struct StaticOrder {
    int nM, nN, nwg, G, c;
    __host__ __device__ void init(int M, int N, int G_, int c_) { nM = M / BM; nN = N / BM; nwg = nM * nN; G = G_; c = c_; }
    __host__ __device__ bool next(int i, Unit& u) const {
        const long L = (long)i * G + c; if (L >= nwg) return false;
        int wgid = (int)L; { const int q = nwg / NXCD, r = nwg % NXCD, xcd = wgid % NXCD, off = wgid / NXCD; wgid = (xcd < r ? xcd * (q + 1) : r * (q + 1) + (xcd - r) * q) + off; }
        const int nig = WGM * nN, gid = wgid / nig, fm = gid * WGM, gsz = (nM - fm) < WGM ? (nM - fm) : WGM;
        u.pm = fm + ((wgid % nig) % gsz); u.pn = (wgid % nig) / gsz; return true;
    }
    __device__ __forceinline__ void a_ready(const Unit&) const {}
    __device__ __forceinline__ void done(const Unit&) const {}
};

__device__ __forceinline__ unsigned cvt_pk_bf16(float lo, float hi) { unsigned r; asm volatile("v_cvt_pk_bf16_f32 %0, %1, %2" : "=v"(r) : "v"(lo), "v"(hi)); return r; }
typedef float f32x2 __attribute__((ext_vector_type(2)));
__device__ __forceinline__ f32x2 gelu_pk(f32x2 v) {
    const f32x2 av = __builtin_elementwise_abs(v), d = av * 0.2316418882f + 1.0f;
    f32x2 t; t.x = __builtin_amdgcn_rcpf(d.x); t.y = __builtin_amdgcn_rcpf(d.y);
    f32x2 q = t * 0.5307027145f + (-0.7265760135f); q = q * t + 0.7107068705f; q = q * t + (-0.142248368f); q = q * t + 0.127414796f; q = q * t;
    const f32x2 s = (v * v) * (-0.72134752044f);
    f32x2 e; e.x = __builtin_amdgcn_exp2f(s.x); e.y = __builtin_amdgcn_exp2f(s.y);
    const f32x2 m = v * (q * e), r = v - m;
    f32x2 o; o.x = v.x < 0.f ? m.x : r.x; o.y = v.y < 0.f ? m.y : r.y; return o;
}

template <int ACT  > struct EpiBf16 {
    static constexpr bool PERM = true, AFTER_DRAIN = false; static_assert(ACT == 0 || ACT == 1, "EpiBf16: ACT is 0 (none) or 1 (gelu_pk)");
    bf16_t* O; int ldc; const float* bias; int split_cols; size_t split_stride; float scale0;
    __device__ __forceinline__ void operator()(const f32x4 (&acc)[2][2][4][2], const Unit& u, int wr, int wc, int fr, int fq) const {
        const int row0 = u.pm * BM + wr * 64 + fr; int colt = u.pn * BM; bf16_t* base = O;
        float sc = 1.f; if (split_cols) { const int t = colt / split_cols; base += (size_t)t * split_stride; colt -= t * split_cols; if (t == 0) sc = scale0; }
        const int col0 = colt + wc * 32 + 8 * fq, bcol0 = u.pn * BM + wc * 32 + 8 * fq;
        f32x4 bv[2][2];
#pragma unroll
        for (int bj = 0; bj < 2; ++bj)
#pragma unroll
            for (int n = 0; n < 2; ++n) bv[bj][n] = bias ? *(const f32x4*)(bias + bcol0 + bj * HALF + 4 * n) : (f32x4){0.f, 0.f, 0.f, 0.f};
#pragma unroll
        for (int ai = 0; ai < 2; ++ai)
#pragma unroll
            for (int m = 0; m < 4; ++m) { bf16_t* rowp = base + (size_t)(row0 + ai * HALF + m * 16) * ldc + col0;
#pragma unroll
                for (int bj = 0; bj < 2; ++bj) { f32x4 v0 = acc[ai][bj][m][0] + bv[bj][0], v1 = acc[ai][bj][m][1] + bv[bj][1];
                    if (ACT == 1) { f32x2 a = gelu_pk((f32x2){v0[0], v0[1]}), b = gelu_pk((f32x2){v0[2], v0[3]}), c = gelu_pk((f32x2){v1[0], v1[1]}), d = gelu_pk((f32x2){v1[2], v1[3]});
                        v0 = (f32x4){a.x, a.y, b.x, b.y}; v1 = (f32x4){c.x, c.y, d.x, d.y}; }
                    v0 = v0 * sc; v1 = v1 * sc; u32x4 w; w.x = cvt_pk_bf16(v0[0], v0[1]); w.y = cvt_pk_bf16(v0[2], v0[3]); w.z = cvt_pk_bf16(v1[0], v1[1]); w.w = cvt_pk_bf16(v1[2], v1[3]);
                    *(u32x4*)(rowp + bj * HALF) = w; } }
    }
};
__device__ __forceinline__ float silu_fast(float v) { return v * __builtin_amdgcn_rcpf(1.f + __expf(-v)); }
struct EpiRS {
    static constexpr bool PERM = true, AFTER_DRAIN = false;
    bf16_t* O; int ldc; const float* rs;
    __device__ __forceinline__ void operator()(const f32x4 (&acc)[2][2][4][2], const Unit& u, int wr, int wc, int fr, int fq) const {
        const int row0 = u.pm * BM + wr * 64 + fr, col0 = u.pn * BM + wc * 32 + 8 * fq;
#pragma unroll
        for (int ai = 0; ai < 2; ++ai)
#pragma unroll
            for (int m = 0; m < 4; ++m) { const int r = row0 + ai * HALF + m * 16; const float s = rs[r]; bf16_t* rowp = O + (size_t)r * ldc + col0;
#pragma unroll
                for (int bj = 0; bj < 2; ++bj) { const f32x4 v0 = acc[ai][bj][m][0] * s, v1 = acc[ai][bj][m][1] * s;
                    u32x4 w; w.x = cvt_pk_bf16(v0[0], v0[1]); w.y = cvt_pk_bf16(v0[2], v0[3]); w.z = cvt_pk_bf16(v1[0], v1[1]); w.w = cvt_pk_bf16(v1[2], v1[3]);
                    *(u32x4*)(rowp + bj * HALF) = w; } }
    }
};
struct EpiSwiGLU {
    static constexpr bool PERM = true, AFTER_DRAIN = false;
    bf16_t* O; int ldc; const float* sspart; int Mrows; float eps;
    __device__ __forceinline__ void operator()(const f32x4 (&acc)[2][2][4][2], const Unit& u, int wr, int wc, int fr, int fq) const {
        const int row0 = u.pm * BM + wr * 64 + fr, col0 = u.pn * HALF + wc * 32 + 8 * fq;
#pragma unroll
        for (int ai = 0; ai < 2; ++ai)
#pragma unroll
            for (int m = 0; m < 4; ++m) { const int r = row0 + ai * HALF + m * 16;
                const float ss = (sspart[r] + sspart[Mrows + r]) + (sspart[2 * Mrows + r] + sspart[3 * Mrows + r]);
                const float s = rsqrtf(ss * (1.f / 1024.f) + eps);
                const f32x4 g0 = acc[ai][0][m][0] * s, g1 = acc[ai][0][m][1] * s, u0 = acc[ai][1][m][0] * s, u1 = acc[ai][1][m][1] * s;
                u32x4 w;
                w.x = cvt_pk_bf16(silu_fast(g0[0]) * u0[0], silu_fast(g0[1]) * u0[1]); w.y = cvt_pk_bf16(silu_fast(g0[2]) * u0[2], silu_fast(g0[3]) * u0[3]);
                w.z = cvt_pk_bf16(silu_fast(g1[0]) * u1[0], silu_fast(g1[1]) * u1[1]); w.w = cvt_pk_bf16(silu_fast(g1[2]) * u1[2], silu_fast(g1[3]) * u1[3]);
                *(u32x4*)(O + (size_t)r * ldc + col0) = w; }
    }
};
struct EpiResid {
    static constexpr bool PERM = false, AFTER_DRAIN = true;
    const float* base; float* out; bf16_t* outb; float* sspart; int Mrows;
    __device__ __forceinline__ void fused(f32x4 (&acc)[2][2][4][2], const Unit& u, int wr, int wc, int fr, int fq, PG8_LAS unsigned char* lds, int wid, int lane) const {
        typedef unsigned u32x2v __attribute__((ext_vector_type(2)));
        PG8_LAS float* P = (PG8_LAS float*)lds;
        const int col0 = u.pn * BM + wc * 32 + 4 * fq;
#pragma unroll
        for (int ai = 0; ai < 2; ++ai)
#pragma unroll
            for (int m = 0; m < 4; ++m) { const int rl = ai * HALF + wr * 64 + m * 16 + fr; const size_t off = (size_t)(u.pm * BM + rl) * 1024 + col0; float q = 0.f;
#pragma unroll
                for (int bj = 0; bj < 2; ++bj)
#pragma unroll
                    for (int n = 0; n < 2; ++n) { const f32x4 bs = *(const f32x4*)(base + off + bj * HALF + n * 16); const f32x4 o = bs + acc[ai][bj][m][n];
                        *(f32x4*)(out + off + bj * HALF + n * 16) = o;
                        if (outb) { u32x2v w; w.x = cvt_pk_bf16(o[0], o[1]); w.y = cvt_pk_bf16(o[2], o[3]); *(u32x2v*)(outb + off + bj * HALF + n * 16) = w; }
                        q += (o[0] * o[0] + o[1] * o[1]) + (o[2] * o[2] + o[3] * o[3]); }
                q += __shfl_xor(q, 16); q += __shfl_xor(q, 32);
                if (fq == 0) P[rl * 4 + wc] = q;
                asm volatile("" ::: "memory"); }
        asm volatile("s_waitcnt lgkmcnt(0)" ::: "memory"); __builtin_amdgcn_s_barrier(); asm volatile("" ::: "memory");
        const int t = wid * 64 + lane;
        if (t < 256) { const float s = (P[t * 4 + 0] + P[t * 4 + 1]) + (P[t * 4 + 2] + P[t * 4 + 3]); sspart[(size_t)u.pn * Mrows + u.pm * BM + t] = s; }
        asm volatile("s_waitcnt lgkmcnt(0)" ::: "memory"); __builtin_amdgcn_s_barrier(); asm volatile("" ::: "memory");
    }
};
template <class Epi, class Sched, bool ALIGN_EPI = false, bool SP2 = false>
__device__ __forceinline__ void gemm_phase(PG8_LAS unsigned char* lds, const Gemm g, const Sched& S, const Epi& E) {
    const int tid = threadIdx.x, wid = __builtin_amdgcn_readfirstlane(tid >> 6), lane = tid & 63, wr = wid >> 2, wc = wid & 3, fr = lane & 15, fq = lane >> 4;
    const int K = g.K, nt = K / BK;
    unsigned voffA[2], voffB[2];
#pragma unroll
    for (int i = 0; i < 2; ++i) { int R, C; stage_rc(tid * 16 + i * 8192, R, C); const int Rb = Epi::PERM ? ((R & ~31) + perm32(R & 31)) : R;
        voffA[i] = (unsigned)(R * K + C) * 2u; voffB[i] = (unsigned)(Rb * K + C) * 2u; }
    const size_t kstep = (size_t)(BK * 2);
    const size_t hstep = (size_t)HALF * K * 2;
    const size_t tstep = 2 * hstep;
    const unsigned ldsw = (unsigned)wid * 1024u;
    const int aoff = lds_byte(wr * 64 + fr, fq * 8), boff = lds_byte(wc * 32 + fr, fq * 8);
#define PG8_SA(b, h) (((b) * 2 + (h)) * HTB)
#define PG8_SB(b, h) ((4 + (b) * 2 + (h)) * HTB)
#define PG8_STAGE(bufoff, gbase, voff) do { _Pragma("unroll") for (int _i = 0; _i < 2; ++_i) \
        __builtin_amdgcn_global_load_lds((const unsigned*)((const char*)(gbase) + (voff)[_i]), (PG8_LAS unsigned*)(lds + (bufoff) + ldsw + _i * 8192), 16, 0, 0); } while (0)
#define PG8_LDA(dst, b, h) do { _Pragma("unroll") for (int m = 0; m < 4; ++m) _Pragma("unroll") for (int k = 0; k < 2; ++k) dst[m][k] = *(const PG8_LAS bf16x8*)(lds + PG8_SA(b, h) + aoff + m * 2048 + k * 1024); } while (0)
#define PG8_LDB(dst, b, h) do { _Pragma("unroll") for (int n = 0; n < 2; ++n) _Pragma("unroll") for (int k = 0; k < 2; ++k) dst[n][k] = *(const PG8_LAS bf16x8*)(lds + PG8_SB(b, h) + boff + n * 2048 + k * 1024); } while (0)
#define PG8_MMA(ai, bj, At, Bt) do { __builtin_amdgcn_s_setprio(1); _Pragma("unroll") for (int m = 0; m < 4; ++m) _Pragma("unroll") for (int n = 0; n < 2; ++n) _Pragma("unroll") for (int k = 0; k < 2; ++k) \
        acc[ai][bj][m][n] = __builtin_amdgcn_mfma_f32_16x16x32_bf16(Bt[n][k], At[m][k], acc[ai][bj][m][n], 0, 0, 0); __builtin_amdgcn_s_setprio(0); } while (0)
#define PG8_WAIT_V(n) asm volatile("s_waitcnt vmcnt(" #n ")" ::: "memory")
#define PG8_WAIT_L(n) asm volatile("s_waitcnt lgkmcnt(" #n ")" ::: "memory")
#define PG8_BAR __builtin_amdgcn_s_barrier()
#define PG8_SCHED __builtin_amdgcn_sched_barrier(0)
    Unit cur, nxt; int ui = 0;
    if (!S.next(0, cur)) return;
    f32x4 acc[2][2][4][2];
#pragma unroll
    for (int a = 0; a < 2; ++a)
#pragma unroll
        for (int b = 0; b < 2; ++b)
#pragma unroll
            for (int m = 0; m < 4; ++m)
#pragma unroll
                for (int n = 0; n < 2; ++n) acc[a][b][m][n] = (f32x4){0.f, 0.f, 0.f, 0.f};
    bf16x8 At[4][2], B0[2][2], B1[2][2];
    const char* cA = (const char*)g.A + (size_t)cur.pm * tstep; const char* cB = (const char*)g.Bt + (size_t)cur.pn * tstep;
    S.a_ready(cur);
    if constexpr (SP2) {
        PG8_STAGE(PG8_SB(0, 0), cB, voffB); PG8_STAGE(PG8_SB(0, 1), cB + hstep, voffB); PG8_STAGE(PG8_SA(0, 0), cA, voffA); PG8_STAGE(PG8_SA(0, 1), cA + hstep, voffA);
        if (wr == 1) PG8_BAR;
        PG8_WAIT_V(2); PG8_BAR;
        PG8_STAGE(PG8_SB(1, 0), cB + kstep, voffB); PG8_STAGE(PG8_SA(1, 0), cA + kstep, voffA); PG8_STAGE(PG8_SB(1, 1), cB + hstep + kstep, voffB);
        PG8_WAIT_V(6); PG8_BAR;
    } else {
        PG8_STAGE(PG8_SB(0, 0), cB, voffB); PG8_STAGE(PG8_SA(0, 0), cA, voffA); PG8_STAGE(PG8_SB(0, 1), cB + hstep, voffB); PG8_STAGE(PG8_SA(0, 1), cA + hstep, voffA);
        if (wr == 1) PG8_BAR;
        PG8_WAIT_V(4); PG8_BAR;
        PG8_STAGE(PG8_SB(1, 0), cB + kstep, voffB); PG8_STAGE(PG8_SA(1, 0), cA + kstep, voffA); PG8_STAGE(PG8_SB(1, 1), cB + hstep + kstep, voffB);
        PG8_WAIT_V(6); PG8_BAR;
    }
    for (;;) {
        const bool has_next = S.next(ui + 1, nxt);
        const char* nA = has_next ? (const char*)g.A + (size_t)nxt.pm * tstep : cA; const char* nB = has_next ? (const char*)g.Bt + (size_t)nxt.pn * tstep : cB;
        for (int t = 0; t < nt; t += 2) {
            const bool last = (t == nt - 2);
            const char* a1 = cA + (size_t)(t + 1) * kstep;
            const char* a2 = last ? nA : cA + (size_t)(t + 2) * kstep; const char* b2 = last ? nB : cB + (size_t)(t + 2) * kstep;
            const char* a3 = a2 + kstep; const char* b3 = b2 + kstep;
            if (last && has_next) S.a_ready(nxt);
            if constexpr (SP2) {
            PG8_LDB(B0, 0, 0); PG8_LDB(B1, 0, 1); PG8_SCHED; PG8_LDA(At, 0, 0); PG8_STAGE(PG8_SA(1, 1), a1 + hstep, voffA);
            PG8_WAIT_V(8); PG8_WAIT_L(0); PG8_BAR; PG8_MMA(0, 0, At, B0); PG8_MMA(0, 1, At, B1); PG8_BAR; PG8_SCHED;
            PG8_LDA(At, 0, 1); PG8_STAGE(PG8_SB(0, 0), b2, voffB); PG8_STAGE(PG8_SB(0, 1), b2 + hstep, voffB); PG8_STAGE(PG8_SA(0, 0), a2, voffA);
            PG8_WAIT_V(8); PG8_WAIT_L(0); PG8_BAR; PG8_MMA(1, 0, At, B0); PG8_MMA(1, 1, At, B1); PG8_BAR; PG8_SCHED;
            PG8_LDB(B0, 1, 0); PG8_LDB(B1, 1, 1); PG8_SCHED; PG8_LDA(At, 1, 0); PG8_STAGE(PG8_SA(0, 1), a2 + hstep, voffA);
            PG8_WAIT_V(8); PG8_WAIT_L(0); PG8_BAR; PG8_MMA(0, 0, At, B0); PG8_MMA(0, 1, At, B1); PG8_BAR; PG8_SCHED;
            PG8_LDA(At, 1, 1); PG8_STAGE(PG8_SB(1, 0), b3, voffB); PG8_STAGE(PG8_SB(1, 1), b3 + hstep, voffB); PG8_STAGE(PG8_SA(1, 0), a3, voffA);
            PG8_WAIT_V(8); PG8_WAIT_L(0); PG8_BAR; PG8_MMA(1, 0, At, B0); PG8_MMA(1, 1, At, B1); PG8_BAR; PG8_SCHED;
            } else {
            PG8_LDB(B0, 0, 0); PG8_SCHED; PG8_LDA(At, 0, 0); PG8_STAGE(PG8_SA(1, 1), a1 + hstep, voffA);
            PG8_WAIT_L(8); PG8_BAR; PG8_WAIT_L(0); PG8_MMA(0, 0, At, B0); PG8_BAR; PG8_SCHED;
            PG8_LDB(B1, 0, 1); PG8_STAGE(PG8_SB(0, 0), b2, voffB);
            PG8_BAR; PG8_WAIT_L(0); PG8_MMA(0, 1, At, B1); PG8_BAR;
            PG8_LDA(At, 0, 1); PG8_STAGE(PG8_SA(0, 0), a2, voffA);
            PG8_BAR; PG8_WAIT_L(0); PG8_MMA(1, 0, At, B0); PG8_BAR; PG8_SCHED;
            PG8_STAGE(PG8_SB(0, 1), b2 + hstep, voffB);
            PG8_WAIT_V(6); PG8_BAR; PG8_MMA(1, 1, At, B1); PG8_BAR;
            PG8_LDB(B0, 1, 0); PG8_SCHED; PG8_LDA(At, 1, 0); PG8_STAGE(PG8_SA(0, 1), a2 + hstep, voffA);
            PG8_WAIT_L(8); PG8_BAR; PG8_WAIT_L(0); PG8_MMA(0, 0, At, B0); PG8_BAR; PG8_SCHED;
            PG8_LDB(B1, 1, 1); PG8_STAGE(PG8_SB(1, 0), b3, voffB);
            PG8_BAR; PG8_WAIT_L(0); PG8_MMA(0, 1, At, B1); PG8_BAR;
            PG8_LDA(At, 1, 1); PG8_STAGE(PG8_SA(1, 0), a3, voffA);
            PG8_BAR; PG8_WAIT_L(0); PG8_MMA(1, 0, At, B0); PG8_BAR; PG8_SCHED;
            PG8_STAGE(PG8_SB(1, 1), b3 + hstep, voffB);
            PG8_WAIT_V(6); PG8_BAR; PG8_MMA(1, 1, At, B1); PG8_BAR;
            }
        }
        if constexpr (ALIGN_EPI) { if (wr == 0) PG8_BAR; }
        if constexpr (!Epi::AFTER_DRAIN) { E(acc, cur, wr, wc, fr, fq); S.done(cur); }
        if (!has_next) break;
#pragma unroll
        for (int a = 0; a < 2; ++a)
#pragma unroll
            for (int b = 0; b < 2; ++b)
#pragma unroll
                for (int m = 0; m < 4; ++m)
#pragma unroll
                    for (int n = 0; n < 2; ++n) acc[a][b][m][n] = (f32x4){0.f, 0.f, 0.f, 0.f};
        cur = nxt; cA = nA; cB = nB; ++ui;
        if constexpr (ALIGN_EPI) { if (wr == 1) PG8_BAR; }
    }
    PG8_WAIT_V(0);
    if constexpr (!ALIGN_EPI) { if (wr == 0) PG8_BAR; }
    PG8_BAR;
    if constexpr (Epi::AFTER_DRAIN) { E.fused(acc, cur, wr, wc, fr, fq, lds, wid, lane); S.done(cur); }
#undef PG8_SA
#undef PG8_SB
#undef PG8_STAGE
#undef PG8_LDA
#undef PG8_LDB
#undef PG8_MMA
#undef PG8_WAIT_V
#undef PG8_WAIT_L
#undef PG8_BAR
#undef PG8_SCHED
}
}
#define GAS __attribute__((address_space(1)))
#define LAS __attribute__((address_space(3)))
typedef unsigned short bf16;
typedef unsigned v4u __attribute__((ext_vector_type(4)));
typedef unsigned v2u __attribute__((ext_vector_type(2)));
typedef float f32x4 __attribute__((ext_vector_type(4)));
typedef short bf16x8 __attribute__((ext_vector_type(8)));
typedef float f32x16 __attribute__((ext_vector_type(16)));

constexpr int D_MODEL = 1024, BATCH = 8, SEQ = 2048, M = BATCH * SEQ;
constexpr int D_IN = 2312, NPROJ = 2304, D_FF = 2816;
constexpr int PZ = 0, PX = 512, PB = 1024, PC = 1280, PQ = 1536, PK = 2048, PV = 2176;
constexpr int W_IN_DT = 1536;
constexpr float EPS = 1e-5f;
constexpr size_t MiB = 1u << 20;
constexpr size_t WS_DTRAW = MiB / 2, WS_DTV = 1 * MiB, WS_ACUM = 3 * MiB / 2, WS_RS1 = 2 * MiB, WS_SS2 = 2 * MiB + 256 * 1024, WS_SS3 = 2 * MiB + 512 * 1024, WS_ALAST = 2 * MiB + 768 * 1024;
constexpr size_t WS_WIN = 4 * MiB, WS_WO = 9 * MiB, WS_WGU = 11 * MiB, WS_WD = 22 * MiB;
constexpr size_t WS_XB = 28 * MiB, WS_YMIX = 28 * MiB;
constexpr size_t WS_PROJ = 60 * MiB, WS_XC = 132 * MiB, WS_STATES = 164 * MiB, WS_HPREV = 196 * MiB;
constexpr size_t WS_X2 = 60 * MiB, WS_X2B = 124 * MiB, WS_ACT = 156 * MiB;
static_assert(WS_ACT + (size_t)M * D_FF * 2 <= 256 * MiB, "ws map");
constexpr int LDS_BYTES = 155648;
constexpr int NWAVES = 8;

__device__ __forceinline__ float bf2f(unsigned short b) { return __uint_as_float(((unsigned)b) << 16); }
__device__ __forceinline__ unsigned f2bf(float f) { unsigned u = __float_as_uint(f); return (u + 0x7fffu + ((u >> 16) & 1u)) >> 16; }
__device__ __forceinline__ unsigned pk2(float lo, float hi) { return f2bf(lo) | (f2bf(hi) << 16); }
__device__ __forceinline__ float silu_f(float v) { return v / (1.f + __expf(-v)); }
__device__ __forceinline__ float softplus_f(float v) { return v > 20.f ? v : log1pf(__expf(v)); }
__device__ __forceinline__ float wave_sum(float v) {
#pragma unroll
    for (int o = 1; o < 64; o <<= 1) v += __shfl_xor(v, o);
    return v;
}
#define LDS_WAIT() asm volatile("s_waitcnt lgkmcnt(0)" ::: "memory")

__device__ __forceinline__ void p0_transpose_item(const float* W, int ldw, int col_off, int K, const float* kscale, bf16* WT, int mode, int row_off, int nblk, LAS float* scr, int item, int lane) {
    const int kb = item / nblk, nb = item % nblk, k0 = 64 * kb, n0 = 32 * nb;
#pragma unroll 8
    for (int i = 0; i < 32; ++i) { const int kk = 2 * i + (lane >> 5); float v = W[(size_t)(k0 + kk) * ldw + col_off + n0 + (lane & 31)]; if (kscale) v *= kscale[k0 + kk]; scr[kk * 33 + (lane & 31)] = v; }
    LDS_WAIT();
    const int c = lane & 7;
#pragma unroll
    for (int j = 0; j < 4; ++j) { const int n = (lane >> 3) + 8 * j; const LAS float* s = scr + (8 * c) * 33 + n;
        v4u o; o.x = pk2(s[0 * 33], s[1 * 33]); o.y = pk2(s[2 * 33], s[3 * 33]); o.z = pk2(s[4 * 33], s[5 * 33]); o.w = pk2(s[6 * 33], s[7 * 33]);
        const int nn = n0 + n; const int drow = mode == 0 ? row_off + nn : 256 * (nn >> 7) + (nn & 127) + row_off;
        *(v4u*)(WT + (size_t)drow * K + k0 + 8 * c) = o; }
    LDS_WAIT();
}

typedef float f32x2_t __attribute__((ext_vector_type(2))); typedef __bf16 bf16x2_t __attribute__((ext_vector_type(2)));
__device__ __forceinline__ unsigned cvtpk(float lo, float hi) { f32x2_t v = {lo, hi}; bf16x2_t b = __builtin_convertvector(v, bf16x2_t); return __builtin_bit_cast(unsigned, b); }
__device__ __forceinline__ int crow(int i, int h) { return (i & 3) + 8 * (i >> 2) + 4 * h; }
#define MFMA32(a, b, c) __builtin_amdgcn_mfma_f32_32x32x16_bf16((a), (b), (c), 0, 0, 0)
#define PACK_STEP(x, s) __builtin_bit_cast(bf16x8, (v4u){cvtpk((x)[8 * (s)], (x)[8 * (s) + 1]), cvtpk((x)[8 * (s) + 2], (x)[8 * (s) + 3]), cvtpk((x)[8 * (s) + 4], (x)[8 * (s) + 5]), cvtpk((x)[8 * (s) + 6], (x)[8 * (s) + 7])})
__device__ __forceinline__ bf16x8 lds_frag_perm(const LAS bf16* p) { const v2u lo = *(const LAS v2u*)p, hi = *(const LAS v2u*)(p + 8); return __builtin_bit_cast(bf16x8, (v4u){lo.x, lo.y, hi.x, hi.y}); }

constexpr int AT_KS = 72, AT_VS = 264;
constexpr int AT_VT_OFF = 256 * AT_KS * 2;
__device__ __forceinline__ void attn_phase(LAS unsigned char* lds, const bf16* proj, const float* sinks, bf16* ymix, int G, int bx, int tid, int lane, int wave) {
    LAS bf16* Ks = (LAS bf16*)lds;
    LAS bf16* Vt = (LAS bf16*)(lds + AT_VT_OFF);
    const int r = lane & 31, h = lane >> 5;
    const float LOG2E = 1.4426950408889634f, SC2 = 0.125f * LOG2E;
    for (int item = bx; item < 256; item += G) {
        const int kvh = item & 1, qb = (item >> 1) & 15, b = item >> 5;
        const int m0 = b * SEQ + qb * 128;
        __syncthreads();
#pragma unroll
        for (int i = 0; i < 4; ++i) { const int c = tid + 512 * i, row = c >> 3, ch = c & 7; v4u val = (v4u){0u, 0u, 0u, 0u};
            if (qb > 0 || row >= 128) val = *(const v4u*)(proj + (size_t)(m0 - 128 + row) * NPROJ + PK + kvh * 64 + ch * 8);
            *(LAS v4u*)(Ks + row * AT_KS + ch * 8) = val; }
#pragma unroll
        for (int i = 0; i < 2; ++i) { const int c = tid + 512 * i, kp = c & 127, ch = c >> 7; v4u va = (v4u){0u, 0u, 0u, 0u}, vb = va;
            if (qb > 0 || kp >= 64) { const bf16* src = proj + (size_t)(m0 - 128 + 2 * kp) * NPROJ + PV + kvh * 64 + ch * 8; va = *(const v4u*)src; vb = *(const v4u*)(src + NPROJ); }
#pragma unroll
            for (int e = 0; e < 8; ++e) { const unsigned lo = (va[e >> 1] >> (16 * (e & 1))) & 0xffffu, hi = (vb[e >> 1] >> (16 * (e & 1))) & 0xffffu;
                *(LAS unsigned*)(Vt + (ch * 8 + e) * AT_VS + 2 * kp) = lo | (hi << 16); } }
        __syncthreads();
        const int hq = kvh * 4 + (wave >> 1);
        const float sink2 = sinks[hq] * LOG2E;
        for (int jj = 0; jj < 2; ++jj) {
            const int j = 2 * (wave & 1) + jj;
            const size_t qrow = (size_t)(m0 + 32 * j + r);
            bf16x8 qf[4];
#pragma unroll
            for (int ks = 0; ks < 4; ++ks) qf[ks] = *(const bf16x8*)(proj + qrow * NPROJ + PQ + hq * 64 + 16 * ks + 8 * h);
            f32x16 s[5];
#pragma unroll
            for (int kb = 0; kb < 5; ++kb) {
#pragma unroll
                for (int i = 0; i < 16; ++i) s[kb][i] = 0.f;
#pragma unroll
                for (int ks = 0; ks < 4; ++ks) { const bf16x8 a = *(const LAS bf16x8*)(Ks + (32 * (j + kb) + r) * AT_KS + 16 * ks + 8 * h); s[kb] = MFMA32(a, qf[ks], s[kb]); }
            }
            const int qp = 128 + 32 * j + r;
            float mx = sink2;
#pragma unroll
            for (int kb = 0; kb < 5; ++kb)
#pragma unroll
                for (int i = 0; i < 16; ++i) { const int kp = 32 * (j + kb) + crow(i, h);
                    const bool valid = (kp <= qp) && (kp > qp - 128) && (qb > 0 || kp >= 128);
                    const float t = valid ? s[kb][i] * SC2 : -INFINITY; s[kb][i] = t; mx = fmaxf(mx, t); }
            mx = fmaxf(mx, __shfl_xor(mx, 32));
            float sum = 0.f;
#pragma unroll
            for (int kb = 0; kb < 5; ++kb)
#pragma unroll
                for (int i = 0; i < 16; ++i) { const float p = __builtin_amdgcn_exp2f(s[kb][i] - mx); s[kb][i] = p; sum += p; }
            sum += __shfl_xor(sum, 32);
            sum += __builtin_amdgcn_exp2f(sink2 - mx);
            const float inv = 1.f / sum;
            f32x16 o[2];
#pragma unroll
            for (int db = 0; db < 2; ++db)
#pragma unroll
                for (int i = 0; i < 16; ++i) o[db][i] = 0.f;
#pragma unroll
            for (int kb = 0; kb < 5; ++kb)
#pragma unroll
                for (int st = 0; st < 2; ++st) { const bf16x8 pb = PACK_STEP(s[kb], st);
#pragma unroll
                    for (int db = 0; db < 2; ++db) { const bf16x8 a = lds_frag_perm(Vt + (32 * db + r) * AT_VS + 32 * (j + kb) + 16 * st + 4 * h); o[db] = MFMA32(a, pb, o[db]); } }
            bf16* orow = ymix + qrow * 1024 + 512 + hq * 64;
#pragma unroll
            for (int db = 0; db < 2; ++db)
#pragma unroll
                for (int g = 0; g < 4; ++g) { v2u w; w.x = cvtpk(o[db][4 * g] * inv, o[db][4 * g + 1] * inv); w.y = cvtpk(o[db][4 * g + 2] * inv, o[db][4 * g + 3] * inv);
                    *(v2u*)(orow + 32 * db + 8 * g + 4 * h) = w; }
        }
    }
    __syncthreads();
}
typedef short v4i16_t __attribute__((ext_vector_type(4)));
__device__ __forceinline__ v2u tr_read(const LAS bf16* p) { return __builtin_bit_cast(v2u, __builtin_amdgcn_ds_read_tr16_b64_v4i16((LAS v4i16_t*)p)); }
__device__ __forceinline__ bf16x8 tr_frag(const LAS bf16* img, int RS, int klo, int khi, int c0, int lane) {
    const int i16 = lane & 15, q = i16 >> 2, p = i16 & 3, blk = (lane >> 4) & 1;
    const v2u lo = tr_read(img + (klo + q) * RS + c0 + 16 * blk + 4 * p), hi = tr_read(img + (khi + q) * RS + c0 + 16 * blk + 4 * p);
    return __builtin_bit_cast(bf16x8, (v4u){lo.x, lo.y, hi.x, hi.y});
}

constexpr int SA_XS = 288, SA_BS = 160;
constexpr int SA_B_OFF = 128 * SA_XS * 2, SA_S_OFF = SA_B_OFF + 128 * SA_BS * 2;
__device__ __forceinline__ void ssd_a_phase(LAS unsigned char* lds, const bf16* proj, const float* dtraw, const float* conv_w, const float* conv_b, const float* dt_bias, const float* a_log,
                                            bf16* xc, float* dtv, float* acum, float* alast, float* states, int G, int bx, int tid, int lane, int wave) {
    LAS bf16* Xs = (LAS bf16*)lds; LAS bf16* Bs = (LAS bf16*)(lds + SA_B_OFF);
    LAS float* dts = (LAS float*)(lds + SA_S_OFF); LAS float* acs = dts + 512; LAS float* tot = acs + 512;
    const int r = lane & 31, h = lane >> 5;
    for (int item = bx; item < 256; item += G) {
        const int g = item & 1, c = (item >> 1) & 15, b = item >> 5, m0 = b * SEQ + c * 128;
        __syncthreads();
        {
            const int hl = tid >> 7, t = tid & 127, hd = 4 * g + hl; const size_t m = (size_t)(m0 + t);
            const float dt = softplus_f(dtraw[m * 8 + hd] + dt_bias[hd]);
            float v = dt * (-__expf(a_log[hd]));
#pragma unroll
            for (int o = 1; o < 64; o <<= 1) { const float n = __shfl_up(v, o); if (lane >= o) v += n; }
            if (lane == 63) tot[wave] = v;
            __syncthreads();
            if (wave & 1) v += tot[wave - 1];
            dts[tid] = dt; acs[tid] = v; dtv[m * 8 + hd] = dt; acum[m * 8 + hd] = v;
            if (t == 127) alast[(b * 16 + c) * 8 + hd] = v;
            __syncthreads();
        }
        {
            const int cgk = lane, ts = wave;
            const int scol = cgk < 32 ? PX + 256 * g + 8 * cgk : (cgk < 48 ? PB + 128 * g + 8 * (cgk - 32) : PC + 128 * g + 8 * (cgk - 48));
            const int dcol = cgk < 32 ? 256 * g + 8 * cgk : (cgk < 48 ? 512 + 128 * g + 8 * (cgk - 32) : 768 + 128 * g + 8 * (cgk - 48));
            float w[4][8], bias[8];
#pragma unroll
            for (int k = 0; k < 4; ++k) { const f32x4 a = *(const f32x4*)(conv_w + k * 1024 + dcol), bq = *(const f32x4*)(conv_w + k * 1024 + dcol + 4);
                w[k][0] = a.x; w[k][1] = a.y; w[k][2] = a.z; w[k][3] = a.w; w[k][4] = bq.x; w[k][5] = bq.y; w[k][6] = bq.z; w[k][7] = bq.w; }
            { const f32x4 a = *(const f32x4*)(conv_b + dcol), bq = *(const f32x4*)(conv_b + dcol + 4);
                bias[0] = a.x; bias[1] = a.y; bias[2] = a.z; bias[3] = a.w; bias[4] = bq.x; bias[5] = bq.y; bias[6] = bq.z; bias[7] = bq.w; }
            const int hl = (cgk >> 3) & 3; const float al = acs[hl * 128 + 127];
            float win[4][8];
#pragma unroll
            for (int tt = 0; tt < 19; ++tt) {
                const int trow = 16 * ts - 3 + tt;
                v4u raw = (v4u){0u, 0u, 0u, 0u};
                if (c * 128 + trow >= 0) raw = *(const v4u*)(proj + (size_t)(m0 + trow) * NPROJ + scol);
#pragma unroll
                for (int e = 0; e < 4; ++e) { win[tt & 3][2 * e] = __uint_as_float(raw[e] << 16); win[tt & 3][2 * e + 1] = __uint_as_float(raw[e] & 0xffff0000u); }
                if (tt >= 3) {
                    float o[8];
#pragma unroll
                    for (int e = 0; e < 8; ++e) { float a = bias[e];
#pragma unroll
                        for (int k = 0; k < 4; ++k) a += w[k][e] * win[(tt - 3 + k) & 3][e];
                        o[e] = silu_f(a); }
                    *(v4u*)(xc + (size_t)(m0 + trow) * 1024 + dcol) = (v4u){cvtpk(o[0], o[1]), cvtpk(o[2], o[3]), cvtpk(o[4], o[5]), cvtpk(o[6], o[7])};
                    if (cgk < 32) { const float sc = dts[hl * 128 + trow] * __expf(al - acs[hl * 128 + trow]);
                        *(LAS v4u*)(Xs + trow * SA_XS + 8 * cgk) = (v4u){cvtpk(o[0] * sc, o[1] * sc), cvtpk(o[2] * sc, o[3] * sc), cvtpk(o[4] * sc, o[5] * sc), cvtpk(o[6] * sc, o[7] * sc)}; }
                    else if (cgk < 48) *(LAS v4u*)(Bs + trow * SA_BS + 8 * (cgk - 32)) = (v4u){cvtpk(o[0], o[1]), cvtpk(o[2], o[3]), cvtpk(o[4], o[5]), cvtpk(o[6], o[7])};
                }
            }
        }
        __syncthreads();
        {
            const int hl = wave >> 1, pb = wave & 1, c0 = hl * 64 + pb * 32;
            f32x16 acc[4];
#pragma unroll
            for (int nb = 0; nb < 4; ++nb)
#pragma unroll
                for (int i = 0; i < 16; ++i) acc[nb][i] = 0.f;
#pragma unroll
            for (int ks = 0; ks < 8; ++ks) { const int k0 = 16 * ks; const bf16x8 a = tr_frag(Xs, SA_XS, k0 + 8 * h, k0 + 8 * h + 4, c0, lane);
#pragma unroll
                for (int nb = 0; nb < 4; ++nb) { const bf16x8 bb = tr_frag(Bs, SA_BS, k0 + 8 * h, k0 + 8 * h + 4, 32 * nb, lane); acc[nb] = MFMA32(a, bb, acc[nb]); } }
            float* dst = states + ((size_t)((b * 16 + c) * 8 + 4 * g + hl) * 64 + 32 * pb) * 128;
#pragma unroll
            for (int nb = 0; nb < 4; ++nb)
#pragma unroll
                for (int i = 0; i < 16; ++i) dst[crow(i, h) * 128 + 32 * nb + r] = acc[nb][i];
        }
    }
    __syncthreads();
}

__device__ __forceinline__ void ssd_scan_phase(const float* states, const float* alast, bf16* hprev, int G, int bx, int tid) {
    for (int e = bx * (NWAVES * 64) + tid; e < 8 * 8 * 64 * 32; e += G * NWAVES * 64) {
        const int n4 = e & 31, p = (e >> 5) & 63, hd = (e >> 11) & 7, b = e >> 14;
        f32x4 st = (f32x4){0.f, 0.f, 0.f, 0.f};
#pragma unroll 4
        for (int c = 0; c < 16; ++c) { const size_t idx = ((size_t)((b * 16 + c) * 8 + hd) * 64 + p) * 128 + 4 * n4;
            *(v2u*)(hprev + idx) = (v2u){cvtpk(st.x, st.y), cvtpk(st.z, st.w)};
            const float dec = __expf(alast[(b * 16 + c) * 8 + hd]);
            st = st * dec + *(const f32x4*)(states + idx); }
    }
}

constexpr int SB_BS = 136, SB_XS = 288, SB_YS = 260;
constexpr int SB_C_OFF = 128 * SB_BS * 2, SB_X_OFF = 2 * SB_C_OFF, SB_S_OFF = SB_X_OFF + 128 * SB_XS * 2;
__device__ __forceinline__ void ssd_b_phase(LAS unsigned char* lds, const bf16* proj, const bf16* xc, const float* dtv, const float* acum, const bf16* hprev, const float* d_skip, const float* nw,
                                            float* ytmp, bf16* ymix, int G, int bx, int tid, int lane, int wave) {
    LAS bf16* Bs = (LAS bf16*)lds; LAS bf16* Cs = (LAS bf16*)(lds + SB_C_OFF); LAS bf16* Xs = (LAS bf16*)(lds + SB_X_OFF);
    LAS float* dts = (LAS float*)(lds + SB_S_OFF); LAS float* acs = dts + 512; LAS float* ssp = acs + 512;
    const int r = lane & 31, h = lane >> 5;
    for (int item = bx; item < 256; item += G) {
        const int g = item & 1, c = (item >> 1) & 15, b = item >> 5, m0 = b * SEQ + c * 128;
        __syncthreads();
#pragma unroll
        for (int i = 0; i < 4; ++i) { const int idx = tid + 512 * i, row = idx >> 4, ch = idx & 15; const bf16* src = xc + (size_t)(m0 + row) * 1024 + 128 * g + 8 * ch;
            *(LAS v4u*)(Bs + row * SB_BS + 8 * ch) = *(const v4u*)(src + 512); *(LAS v4u*)(Cs + row * SB_BS + 8 * ch) = *(const v4u*)(src + 768); }
#pragma unroll
        for (int i = 0; i < 8; ++i) { const int idx = tid + 512 * i, row = idx >> 5, ch = idx & 31; *(LAS v4u*)(Xs + row * SB_XS + 8 * ch) = *(const v4u*)(xc + (size_t)(m0 + row) * 1024 + 256 * g + 8 * ch); }
        { const int hl = tid >> 7, t = tid & 127; dts[tid] = dtv[(size_t)(m0 + t) * 8 + 4 * g + hl]; acs[tid] = acum[(size_t)(m0 + t) * 8 + 4 * g + hl]; }
        __syncthreads();
        const int tb = wave & 3, hp = wave >> 2, t = 32 * tb + r;
        const size_t mt = (size_t)(m0 + t);
        float ssq = 0.f;
#pragma unroll 1
        for (int hh = 0; hh < 2; ++hh) {
            f32x16 yacc[2];
            const int hl = 2 * hp + hh, hd = 4 * g + hl;
            const float act = acs[hl * 128 + t], ea = __expf(act), dsk = d_skip[hd];
#pragma unroll
            for (int pb = 0; pb < 2; ++pb) {
#pragma unroll
                for (int i = 0; i < 16; ++i) yacc[pb][i] = 0.f;
                if (c > 0) { const bf16* hp0 = hprev + ((size_t)((b * 16 + c) * 8 + hd) * 64 + 32 * pb + r) * 128 + 8 * h;
#pragma unroll
                    for (int ks = 0; ks < 8; ++ks) { const bf16x8 a = *(const bf16x8*)(hp0 + 16 * ks), bb = *(const LAS bf16x8*)(Cs + t * SB_BS + 16 * ks + 8 * h); yacc[pb] = MFMA32(a, bb, yacc[pb]); }
#pragma unroll
                    for (int i = 0; i < 16; ++i) yacc[pb][i] *= ea; }
            }
#pragma unroll
            for (int sb = 0; sb < 4; ++sb) if (sb <= tb) {
                f32x16 L;
#pragma unroll
                for (int i = 0; i < 16; ++i) L[i] = 0.f;
#pragma unroll
                for (int ks = 0; ks < 8; ++ks) { const bf16x8 a = *(const LAS bf16x8*)(Bs + (32 * sb + r) * SB_BS + 16 * ks + 8 * h), bb = *(const LAS bf16x8*)(Cs + t * SB_BS + 16 * ks + 8 * h);
                    L = MFMA32(a, bb, L); }
#pragma unroll
                for (int i = 0; i < 16; ++i) { const int s = 32 * sb + crow(i, h); const float v = L[i] * __expf(act - acs[hl * 128 + s]) * dts[hl * 128 + s]; L[i] = (s <= t) ? v : 0.f; }
#pragma unroll
                for (int st = 0; st < 2; ++st) { const bf16x8 pk = PACK_STEP(L, st);
#pragma unroll
                    for (int pb = 0; pb < 2; ++pb) { const bf16x8 a = tr_frag(Xs, SB_XS, 32 * sb + 16 * st + 4 * h, 32 * sb + 16 * st + 8 + 4 * h, hl * 64 + 32 * pb, lane); yacc[pb] = MFMA32(a, pk, yacc[pb]); } }
                asm volatile("" ::: "memory");
            }
#pragma unroll
            for (int pb = 0; pb < 2; ++pb)
#pragma unroll
                for (int q = 0; q < 4; ++q) { const int ch = hl * 64 + 32 * pb + 8 * q + 4 * h;
                    const v2u xv = *(const LAS v2u*)(Xs + t * SB_XS + ch); const v2u zr = *(const v2u*)(proj + mt * NPROJ + PZ + 256 * g + ch);
                    const float v0 = (yacc[pb][4 * q] + dsk * __uint_as_float(xv.x << 16)) * silu_f(__uint_as_float(zr.x << 16));
                    const float v1 = (yacc[pb][4 * q + 1] + dsk * __uint_as_float(xv.x & 0xffff0000u)) * silu_f(__uint_as_float(zr.x & 0xffff0000u));
                    const float v2 = (yacc[pb][4 * q + 2] + dsk * __uint_as_float(xv.y << 16)) * silu_f(__uint_as_float(zr.y << 16));
                    const float v3 = (yacc[pb][4 * q + 3] + dsk * __uint_as_float(xv.y & 0xffff0000u)) * silu_f(__uint_as_float(zr.y & 0xffff0000u));
                    *(f32x4*)(ytmp + mt * 512 + 256 * g + ch) = (f32x4){v0, v1, v2, v3};
                    ssq += (v0 * v0 + v1 * v1) + (v2 * v2 + v3 * v3); }
            asm volatile("" ::: "memory");
        }
        ssq += __shfl_xor(ssq, 32);
        if (h == 0) ssp[hp * 128 + t] = ssq;
        __syncthreads();
        const float rs = rsqrtf((ssp[t] + ssp[128 + t]) * (1.f / 256.f) + EPS);
#pragma unroll
        for (int hh = 0; hh < 2; ++hh)
#pragma unroll
            for (int pb = 0; pb < 2; ++pb)
#pragma unroll
                for (int q = 0; q < 4; ++q) { const int ch = 256 * g + (2 * hp + hh) * 64 + 32 * pb + 8 * q + 4 * h; const f32x4 wv = *(const f32x4*)(nw + ch); const f32x4 v = *(const f32x4*)(ytmp + mt * 512 + ch);
                    *(v2u*)(ymix + mt * 1024 + ch) = (v2u){cvtpk(v.x * rs * wv.x, v.y * rs * wv.y), cvtpk(v.z * rs * wv.z, v.w * rs * wv.w)}; }
    }
    __syncthreads();
}

struct Args { const float* in[16]; float* out; unsigned char* ws; int phmask; int pad; };

__global__ void __launch_bounds__(NWAVES * 64, 2) mega_fwd(Args args) {
    extern __shared__ __attribute__((aligned(16))) unsigned char lds_raw[];
    cg::grid_group grid = cg::this_grid();
    LAS unsigned char* lds = (LAS unsigned char*)lds_raw;
    const int tid = threadIdx.x, lane = tid & 63, wave = __builtin_amdgcn_readfirstlane(tid >> 6);
    const int G = gridDim.x, bx = blockIdx.x;
    const int phmask = args.phmask;
    unsigned char* ws = args.ws;
    const float* x = args.in[0]; const float* norm_mix_w = args.in[1]; const float* w_in = args.in[2];
    const float* w_out = args.in[10]; const float* norm_ffn_w = args.in[11];
    const float* w_gate = args.in[12]; const float* w_up = args.in[13]; const float* w_down = args.in[14]; const float* norm_final_w = args.in[15];
    bf16* WinT = (bf16*)(ws + WS_WIN); bf16* WoT = (bf16*)(ws + WS_WO); bf16* WguT = (bf16*)(ws + WS_WGU); bf16* WdT = (bf16*)(ws + WS_WD);
    bf16* xb = (bf16*)(ws + WS_XB); bf16* ymix = (bf16*)(ws + WS_YMIX); bf16* proj = (bf16*)(ws + WS_PROJ);
    float* dtraw = (float*)(ws + WS_DTRAW); float* rs1 = (float*)(ws + WS_RS1); float* ss2 = (float*)(ws + WS_SS2); float* ss3 = (float*)(ws + WS_SS3);
    bf16* xc = (bf16*)(ws + WS_XC); float* states = (float*)(ws + WS_STATES); bf16* hprev = (bf16*)(ws + WS_HPREV);
    float* dtv = (float*)(ws + WS_DTV); float* acum = (float*)(ws + WS_ACUM); float* alast = (float*)(ws + WS_ALAST);
    float* x2 = (float*)(ws + WS_X2); bf16* x2b = (bf16*)(ws + WS_X2B); bf16* act = (bf16*)(ws + WS_ACT);
#define PH(k) (phmask & (1 << (k)))
#define SEAM(k) do { if (phmask >> ((k) + 1)) grid.sync(); } while (0)

    if (PH(0)) {
        const int gw = bx * NWAVES + wave, NGW = G * NWAVES;
        LAS float* wdt = (LAS float*)(lds + 8 * 8704);
        for (int idx = tid; idx < 1024 * 8; idx += NWAVES * 64) { const int k = idx >> 3, j = idx & 7; wdt[idx] = w_in[(size_t)k * D_IN + W_IN_DT + j] * norm_mix_w[k]; }
        __syncthreads();
        for (int m = gw; m < M; m += NGW) {
            const f32x4* xr = (const f32x4*)(x + (size_t)m * D_MODEL) + lane;
            f32x4 v[4]; float s = 0.f;
#pragma unroll
            for (int j = 0; j < 4; ++j) { v[j] = xr[64 * j]; s += (v[j].x * v[j].x + v[j].y * v[j].y) + (v[j].z * v[j].z + v[j].w * v[j].w); }
            const float rs = rsqrtf(wave_sum(s) * (1.f / D_MODEL) + EPS);
            unsigned long long* o8 = (unsigned long long*)(xb + (size_t)m * D_MODEL) + lane;
#pragma unroll
            for (int j = 0; j < 4; ++j) o8[64 * j] = (unsigned long long)pk2(v[j].x, v[j].y) | ((unsigned long long)pk2(v[j].z, v[j].w) << 32);
            float d[8];
#pragma unroll
            for (int q = 0; q < 8; ++q) d[q] = 0.f;
#pragma unroll
            for (int j = 0; j < 4; ++j)
#pragma unroll
                for (int i = 0; i < 4; ++i) { const int k = 4 * (lane + 64 * j) + i; const float xv = v[j][i];
                    const f32x4 wa = *(const LAS f32x4*)(wdt + k * 8), wb = *(const LAS f32x4*)(wdt + k * 8 + 4);
                    d[0] += xv * wa.x; d[1] += xv * wa.y; d[2] += xv * wa.z; d[3] += xv * wa.w; d[4] += xv * wb.x; d[5] += xv * wb.y; d[6] += xv * wb.z; d[7] += xv * wb.w; }
#pragma unroll
            for (int q = 0; q < 8; ++q) d[q] = wave_sum(d[q]);
            if (lane == 0) { rs1[m] = rs;
                *(f32x4*)(dtraw + (size_t)m * 8) = (f32x4){d[0] * rs, d[1] * rs, d[2] * rs, d[3] * rs}; *(f32x4*)(dtraw + (size_t)m * 8 + 4) = (f32x4){d[4] * rs, d[5] * rs, d[6] * rs, d[7] * rs}; }
        }
        LAS float* scr = (LAS float*)(lds + wave * 8704);
        constexpr int I_IN1 = 16 * 48, I_IN2 = 16 * 24, I_O = 16 * 32, I_G = 16 * 88, I_D = 44 * 32;
        constexpr int NITEMS = I_IN1 + I_IN2 + I_O + 2 * I_G + I_D;
        for (int it = gw; it < NITEMS; it += NGW) {
            int r = it;
            if (r < I_IN1) { p0_transpose_item(w_in, D_IN, 0, 1024, norm_mix_w, WinT, 0, 0, 48, scr, r, lane); continue; } r -= I_IN1;
            if (r < I_IN2) { p0_transpose_item(w_in, D_IN, 1544, 1024, norm_mix_w, WinT, 0, 1536, 24, scr, r, lane); continue; } r -= I_IN2;
            if (r < I_O) { p0_transpose_item(w_out, 1024, 0, 1024, nullptr, WoT, 0, 0, 32, scr, r, lane); continue; } r -= I_O;
            if (r < I_G) { p0_transpose_item(w_gate, D_FF, 0, 1024, norm_ffn_w, WguT, 1, 0, 88, scr, r, lane); continue; } r -= I_G;
            if (r < I_G) { p0_transpose_item(w_up, D_FF, 0, 1024, norm_ffn_w, WguT, 1, 128, 88, scr, r, lane); continue; } r -= I_G;
            p0_transpose_item(w_down, 1024, 0, D_FF, nullptr, WdT, 0, 0, 32, scr, r, lane);
        }
        __syncthreads();
        SEAM(0);
    }
    if (PH(1)) {
        pg8::Gemm g{xb, WinT, M, NPROJ, 1024}; pg8::StaticOrder S; S.init(M, NPROJ, G, bx);
        pg8::EpiRS E{proj, NPROJ, rs1};
        pg8::gemm_phase<pg8::EpiRS, pg8::StaticOrder, true, true>(lds, g, S, E);
        SEAM(1);
    }
    if (PH(2)) {
        attn_phase(lds, proj, args.in[9], ymix, G, bx, tid, lane, wave);
        ssd_a_phase(lds, proj, dtraw, args.in[3], args.in[4], args.in[5], args.in[6], xc, dtv, acum, alast, states, G, bx, tid, lane, wave);
        SEAM(2);
    }
    if (PH(3)) {
        ssd_scan_phase(states, alast, hprev, G, bx, tid);
        SEAM(3);
    }
    if (PH(4)) {
        ssd_b_phase(lds, proj, xc, dtv, acum, hprev, args.in[7], args.in[8], states, ymix, G, bx, tid, lane, wave);
        SEAM(4);
    }
    if (PH(5)) {
        pg8::Gemm g{ymix, WoT, M, 1024, 1024}; pg8::StaticOrder S; S.init(M, 1024, G, bx);
        pg8::EpiResid E{x, x2, x2b, ss2, M};
        pg8::gemm_phase<pg8::EpiResid, pg8::StaticOrder, false, true>(lds, g, S, E);
        SEAM(5);
    }
    if (PH(6)) {
        pg8::Gemm g{x2b, WguT, M, 2 * D_FF, 1024}; pg8::StaticOrder S; S.init(M, 2 * D_FF, G, bx);
        pg8::EpiSwiGLU E{act, D_FF, ss2, M, EPS};
        pg8::gemm_phase<pg8::EpiSwiGLU, pg8::StaticOrder, true, true>(lds, g, S, E);
        SEAM(6);
    }
    if (PH(7)) {
        pg8::Gemm g{act, WdT, M, 1024, D_FF}; pg8::StaticOrder S; S.init(M, 1024, G, bx);
        pg8::EpiResid E{x2, args.out, nullptr, ss3, M};
        pg8::gemm_phase<pg8::EpiResid, pg8::StaticOrder, false, true>(lds, g, S, E);
        SEAM(7);
    }
    if (PH(8)) {
        const int gw = bx * NWAVES + wave, NGW = G * NWAVES;
        for (int m = gw; m < M; m += NGW) {
            f32x4* xr = (f32x4*)(args.out + (size_t)m * D_MODEL) + lane;
            const float ss = (ss3[m] + ss3[M + m]) + (ss3[2 * M + m] + ss3[3 * M + m]);
            const float rs = rsqrtf(ss * (1.f / D_MODEL) + EPS);
#pragma unroll
            for (int j = 0; j < 4; ++j) { const f32x4 v = xr[64 * j]; const f32x4 w = ((const f32x4*)norm_final_w)[lane + 64 * j]; xr[64 * j] = v * rs * w; }
        }
    }
#undef PH
#undef SEAM
}

static int g_grid = 0;
static void launch_mega(const Args& a0, int phmask, hipStream_t stream) {
    Args a = a0; a.phmask = phmask;
    void* kargs[] = {&a};
    hipError_t e = hipLaunchCooperativeKernel((const void*)mega_fwd, dim3(g_grid), dim3(NWAVES * 64), kargs, LDS_BYTES, stream);
    if (e != hipSuccess) fprintf(stderr, "cooperative launch failed: %s (grid %d)\n", hipGetErrorString(e), g_grid);
}
extern "C" void kernel_launch(void* const* d_in, const int* in_sizes, int n_in, void* d_out, int out_size, void* d_ws, size_t ws_size, hipStream_t stream) {
    if (g_grid == 0) {
        int dev = 0, cus = 0, per_cu = 0;
        (void)hipGetDevice(&dev);
        (void)hipDeviceGetAttribute(&cus, hipDeviceAttributeMultiprocessorCount, dev);
        if (hipFuncSetAttribute((const void*)mega_fwd, hipFuncAttributeMaxDynamicSharedMemorySize, LDS_BYTES) != hipSuccess) fprintf(stderr, "hipFuncSetAttribute failed\n");
        if (hipOccupancyMaxActiveBlocksPerMultiprocessor(&per_cu, (const void*)mega_fwd, NWAVES * 64, LDS_BYTES) != hipSuccess || per_cu < 1) { fprintf(stderr, "occupancy query: %d\n", per_cu); per_cu = 1; }
        (void)hipGetLastError();
        g_grid = cus;
    }
    Args a{};
    for (int i = 0; i < 16; ++i) a.in[i] = (const float*)d_in[i];
    a.out = (float*)d_out; a.ws = (unsigned char*)d_ws; a.phmask = 0; a.pad = 0;
    unsigned char* ws = (unsigned char*)d_ws;
    const float* conv_w = (const float*)d_in[3]; const float* conv_b = (const float*)d_in[4]; const float* dt_bias = (const float*)d_in[5];
    const float* a_log = (const float*)d_in[6]; const float* d_skip = (const float*)d_in[7]; const float* ssm_norm_w = (const float*)d_in[8];
    const float* sinks = (const float*)d_in[9];
    bf16* proj = (bf16*)(ws + WS_PROJ); bf16* xc = (bf16*)(ws + WS_XC); float* yssd = (float*)(ws + WS_STATES); bf16* ymix = (bf16*)(ws + WS_YMIX);
    float* dtraw = (float*)(ws + WS_DTRAW);
    launch_mega(a, 0x1FF, stream);
}
```

```cpp
#include <hip/hip_runtime.h>
#include <hip/hip_cooperative_groups.h>
#include <cstdio>
#include <cstdint>
namespace cg = cooperative_groups;
namespace pg8 {
#define PG8_LAS __attribute__((address_space(3)))
typedef unsigned short bf16_t;
typedef short bf16x8 __attribute__((ext_vector_type(8)));
typedef float f32x4 __attribute__((ext_vector_type(4)));
typedef unsigned u32x4 __attribute__((ext_vector_type(4)));
constexpr int BM = 256, BK = 64, HALF = 128, HTB = HALF * BK * 2  , STAGE_BYTES = 8 * HTB, NXCD = 8, WGM = 8;

__host__ __device__ __forceinline__ int lds_byte(int r, int c) { const int st = (r >> 4) * 2 + (c >> 5), rr = r & 15, cc = c & 31, ob = rr * 64 + cc * 2; return st * 1024 + (ob ^ (((ob >> 9) & 1) << 5)); }
__host__ __device__ __forceinline__ void stage_rc(int b, int& R, int& C) { const int st = b / 1024, sb = b % 1024, swz = sb ^ (((sb >> 9) & 1) << 5); R = (st >> 1) * 16 + swz / 64; C = (st & 1) * 32 + (swz % 64) / 2; }
__host__ __device__ __forceinline__ int perm32(int rho) { const int n = rho >> 4, i = rho & 15; return 8 * (i >> 2) + 4 * n + (i & 3); }

struct Unit { int pm, pn; };
struct Gemm { const bf16_t* A; const bf16_t* Bt; int M, N, K; };

struct StaticOrder {
    int nM, nN, nwg, G, c;
    __host__ __device__ void init(int M, int N, int G_, int c_) { nM = M / BM; nN = N / BM; nwg = nM * nN; G = G_; c = c_; }
    __host__ __device__ bool next(int i, Unit& u) const {
        const long L = (long)i * G + c; if (L >= nwg) return false;
        int wgid = (int)L; { const int q = nwg / NXCD, r = nwg % NXCD, xcd = wgid % NXCD, off = wgid / NXCD; wgid = (xcd < r ? xcd * (q + 1) : r * (q + 1) + (xcd - r) * q) + off; }
        const int nig = WGM * nN, gid = wgid / nig, fm = gid * WGM, gsz = (nM - fm) < WGM ? (nM - fm) : WGM;
        u.pm = fm + ((wgid % nig) % gsz); u.pn = (wgid % nig) / gsz; return true;
    }
    __device__ __forceinline__ void a_ready(const Unit&) const {}
    __device__ __forceinline__ void done(const Unit&) const {}
};

__device__ __forceinline__ unsigned cvt_pk_bf16(float lo, float hi) { unsigned r; asm volatile("v_cvt_pk_bf16_f32 %0, %1, %2" : "=v"(r) : "v"(lo), "v"(hi)); return r; }
typedef float f32x2 __attribute__((ext_vector_type(2)));
__device__ __forceinline__ f32x2 gelu_pk(f32x2 v) {
    const f32x2 av = __builtin_elementwise_abs(v), d = av * 0.2316418882f + 1.0f;
    f32x2 t; t.x = __builtin_amdgcn_rcpf(d.x); t.y = __builtin_amdgcn_rcpf(d.y);
    f32x2 q = t * 0.5307027145f + (-0.7265760135f); q = q * t + 0.7107068705f; q = q * t + (-0.142248368f); q = q * t + 0.127414796f; q = q * t;
    const f32x2 s = (v * v) * (-0.72134752044f);
    f32x2 e; e.x = __builtin_amdgcn_exp2f(s.x); e.y = __builtin_amdgcn_exp2f(s.y);
    const f32x2 m = v * (q * e), r = v - m;
    f32x2 o; o.x = v.x < 0.f ? m.x : r.x; o.y = v.y < 0.f ? m.y : r.y; return o;
}

template <int ACT  > struct EpiBf16 {
    static constexpr bool PERM = true, AFTER_DRAIN = false; static_assert(ACT == 0 || ACT == 1, "EpiBf16: ACT is 0 (none) or 1 (gelu_pk)");
    bf16_t* O; int ldc; const float* bias; int split_cols; size_t split_stride; float scale0;
    __device__ __forceinline__ void operator()(const f32x4 (&acc)[2][2][4][2], const Unit& u, int wr, int wc, int fr, int fq) const {
        const int row0 = u.pm * BM + wr * 64 + fr; int colt = u.pn * BM; bf16_t* base = O;
        float sc = 1.f; if (split_cols) { const int t = colt / split_cols; base += (size_t)t * split_stride; colt -= t * split_cols; if (t == 0) sc = scale0; }
        const int col0 = colt + wc * 32 + 8 * fq, bcol0 = u.pn * BM + wc * 32 + 8 * fq;
        f32x4 bv[2][2];
#pragma unroll
        for (int bj = 0; bj < 2; ++bj)
#pragma unroll
            for (int n = 0; n < 2; ++n) bv[bj][n] = bias ? *(const f32x4*)(bias + bcol0 + bj * HALF + 4 * n) : (f32x4){0.f, 0.f, 0.f, 0.f};
#pragma unroll
        for (int ai = 0; ai < 2; ++ai)
#pragma unroll
            for (int m = 0; m < 4; ++m) { bf16_t* rowp = base + (size_t)(row0 + ai * HALF + m * 16) * ldc + col0;
#pragma unroll
                for (int bj = 0; bj < 2; ++bj) { f32x4 v0 = acc[ai][bj][m][0] + bv[bj][0], v1 = acc[ai][bj][m][1] + bv[bj][1];
                    if (ACT == 1) { f32x2 a = gelu_pk((f32x2){v0[0], v0[1]}), b = gelu_pk((f32x2){v0[2], v0[3]}), c = gelu_pk((f32x2){v1[0], v1[1]}), d = gelu_pk((f32x2){v1[2], v1[3]});
                        v0 = (f32x4){a.x, a.y, b.x, b.y}; v1 = (f32x4){c.x, c.y, d.x, d.y}; }
                    v0 = v0 * sc; v1 = v1 * sc; u32x4 w; w.x = cvt_pk_bf16(v0[0], v0[1]); w.y = cvt_pk_bf16(v0[2], v0[3]); w.z = cvt_pk_bf16(v1[0], v1[1]); w.w = cvt_pk_bf16(v1[2], v1[3]);
                    *(u32x4*)(rowp + bj * HALF) = w; } }
    }
};
__device__ __forceinline__ float silu_fast(float v) { return v * __builtin_amdgcn_rcpf(1.f + __expf(-v)); }
struct EpiRS {
    static constexpr bool PERM = true, AFTER_DRAIN = false;
    bf16_t* O; int ldc; const float* rs;
    __device__ __forceinline__ void operator()(const f32x4 (&acc)[2][2][4][2], const Unit& u, int wr, int wc, int fr, int fq) const {
        const int row0 = u.pm * BM + wr * 64 + fr, col0 = u.pn * BM + wc * 32 + 8 * fq;
#pragma unroll
        for (int ai = 0; ai < 2; ++ai)
#pragma unroll
            for (int m = 0; m < 4; ++m) { const int r = row0 + ai * HALF + m * 16; const float s = rs[r]; bf16_t* rowp = O + (size_t)r * ldc + col0;
#pragma unroll
                for (int bj = 0; bj < 2; ++bj) { const f32x4 v0 = acc[ai][bj][m][0] * s, v1 = acc[ai][bj][m][1] * s;
                    u32x4 w; w.x = cvt_pk_bf16(v0[0], v0[1]); w.y = cvt_pk_bf16(v0[2], v0[3]); w.z = cvt_pk_bf16(v1[0], v1[1]); w.w = cvt_pk_bf16(v1[2], v1[3]);
                    *(u32x4*)(rowp + bj * HALF) = w; } }
    }
};
struct EpiSwiGLU {
    static constexpr bool PERM = true, AFTER_DRAIN = false;
    bf16_t* O; int ldc; const float* sspart; int Mrows; float eps;
    __device__ __forceinline__ void operator()(const f32x4 (&acc)[2][2][4][2], const Unit& u, int wr, int wc, int fr, int fq) const {
        const int row0 = u.pm * BM + wr * 64 + fr, col0 = u.pn * HALF + wc * 32 + 8 * fq;
#pragma unroll
        for (int ai = 0; ai < 2; ++ai)
#pragma unroll
            for (int m = 0; m < 4; ++m) { const int r = row0 + ai * HALF + m * 16;
                const float ss = (sspart[r] + sspart[Mrows + r]) + (sspart[2 * Mrows + r] + sspart[3 * Mrows + r]);
                const float s = rsqrtf(ss * (1.f / 1024.f) + eps);
                const f32x4 g0 = acc[ai][0][m][0] * s, g1 = acc[ai][0][m][1] * s, u0 = acc[ai][1][m][0] * s, u1 = acc[ai][1][m][1] * s;
                u32x4 w;
                w.x = cvt_pk_bf16(silu_fast(g0[0]) * u0[0], silu_fast(g0[1]) * u0[1]); w.y = cvt_pk_bf16(silu_fast(g0[2]) * u0[2], silu_fast(g0[3]) * u0[3]);
                w.z = cvt_pk_bf16(silu_fast(g1[0]) * u1[0], silu_fast(g1[1]) * u1[1]); w.w = cvt_pk_bf16(silu_fast(g1[2]) * u1[2], silu_fast(g1[3]) * u1[3]);
                *(u32x4*)(O + (size_t)r * ldc + col0) = w; }
    }
};
struct EpiResid {
    static constexpr bool PERM = false, AFTER_DRAIN = true;
    const float* base; float* out; bf16_t* outb; float* sspart; int Mrows;
    __device__ __forceinline__ void fused(f32x4 (&acc)[2][2][4][2], const Unit& u, int wr, int wc, int fr, int fq, PG8_LAS unsigned char* lds, int wid, int lane) const {
        typedef unsigned u32x2v __attribute__((ext_vector_type(2)));
        PG8_LAS float* P = (PG8_LAS float*)lds;
        const int col0 = u.pn * BM + wc * 32 + 4 * fq;
#pragma unroll
        for (int ai = 0; ai < 2; ++ai)
#pragma unroll
            for (int m = 0; m < 4; ++m) { const int rl = ai * HALF + wr * 64 + m * 16 + fr; const size_t off = (size_t)(u.pm * BM + rl) * 1024 + col0; float q = 0.f;
#pragma unroll
                for (int bj = 0; bj < 2; ++bj)
#pragma unroll
                    for (int n = 0; n < 2; ++n) { const f32x4 bs = *(const f32x4*)(base + off + bj * HALF + n * 16); const f32x4 o = bs + acc[ai][bj][m][n];
                        *(f32x4*)(out + off + bj * HALF + n * 16) = o;
                        if (outb) { u32x2v w; w.x = cvt_pk_bf16(o[0], o[1]); w.y = cvt_pk_bf16(o[2], o[3]); *(u32x2v*)(outb + off + bj * HALF + n * 16) = w; }
                        q += (o[0] * o[0] + o[1] * o[1]) + (o[2] * o[2] + o[3] * o[3]); }
                q += __shfl_xor(q, 16); q += __shfl_xor(q, 32);
                if (fq == 0) P[rl * 4 + wc] = q;
                asm volatile("" ::: "memory"); }
        asm volatile("s_waitcnt lgkmcnt(0)" ::: "memory"); __builtin_amdgcn_s_barrier(); asm volatile("" ::: "memory");
        const int t = wid * 64 + lane;
        if (t < 256) { const float s = (P[t * 4 + 0] + P[t * 4 + 1]) + (P[t * 4 + 2] + P[t * 4 + 3]); sspart[(size_t)u.pn * Mrows + u.pm * BM + t] = s; }
        asm volatile("s_waitcnt lgkmcnt(0)" ::: "memory"); __builtin_amdgcn_s_barrier(); asm volatile("" ::: "memory");
    }
};
template <class Epi, class Sched, bool ALIGN_EPI = false, bool SP2 = false>
__device__ __forceinline__ void gemm_phase(PG8_LAS unsigned char* lds, const Gemm g, const Sched& S, const Epi& E) {
    const int tid = threadIdx.x, wid = __builtin_amdgcn_readfirstlane(tid >> 6), lane = tid & 63, wr = wid >> 2, wc = wid & 3, fr = lane & 15, fq = lane >> 4;
    const int K = g.K, nt = K / BK;
    unsigned voffA[2], voffB[2];
#pragma unroll
    for (int i = 0; i < 2; ++i) { int R, C; stage_rc(tid * 16 + i * 8192, R, C); const int Rb = Epi::PERM ? ((R & ~31) + perm32(R & 31)) : R;
        voffA[i] = (unsigned)(R * K + C) * 2u; voffB[i] = (unsigned)(Rb * K + C) * 2u; }
    const size_t kstep = (size_t)(BK * 2);
    const size_t hstep = (size_t)HALF * K * 2;
    const size_t tstep = 2 * hstep;
    const unsigned ldsw = (unsigned)wid * 1024u;
    const int aoff = lds_byte(wr * 64 + fr, fq * 8), boff = lds_byte(wc * 32 + fr, fq * 8);
#define PG8_SA(b, h) (((b) * 2 + (h)) * HTB)
#define PG8_SB(b, h) ((4 + (b) * 2 + (h)) * HTB)
#define PG8_STAGE(bufoff, gbase, voff) do { _Pragma("unroll") for (int _i = 0; _i < 2; ++_i) \
        __builtin_amdgcn_global_load_lds((const unsigned*)((const char*)(gbase) + (voff)[_i]), (PG8_LAS unsigned*)(lds + (bufoff) + ldsw + _i * 8192), 16, 0, 0); } while (0)
#define PG8_LDA(dst, b, h) do { _Pragma("unroll") for (int m = 0; m < 4; ++m) _Pragma("unroll") for (int k = 0; k < 2; ++k) dst[m][k] = *(const PG8_LAS bf16x8*)(lds + PG8_SA(b, h) + aoff + m * 2048 + k * 1024); } while (0)
#define PG8_LDB(dst, b, h) do { _Pragma("unroll") for (int n = 0; n < 2; ++n) _Pragma("unroll") for (int k = 0; k < 2; ++k) dst[n][k] = *(const PG8_LAS bf16x8*)(lds + PG8_SB(b, h) + boff + n * 2048 + k * 1024); } while (0)
#define PG8_MMA(ai, bj, At, Bt) do { __builtin_amdgcn_s_setprio(1); _Pragma("unroll") for (int m = 0; m < 4; ++m) _Pragma("unroll") for (int n = 0; n < 2; ++n) _Pragma("unroll") for (int k = 0; k < 2; ++k) \
        acc[ai][bj][m][n] = __builtin_amdgcn_mfma_f32_16x16x32_bf16(Bt[n][k], At[m][k], acc[ai][bj][m][n], 0, 0, 0); __builtin_amdgcn_s_setprio(0); } while (0)
#define PG8_WAIT_V(n) asm volatile("s_waitcnt vmcnt(" #n ")" ::: "memory")
#define PG8_WAIT_L(n) asm volatile("s_waitcnt lgkmcnt(" #n ")" ::: "memory")
#define PG8_BAR __builtin_amdgcn_s_barrier()
#define PG8_SCHED __builtin_amdgcn_sched_barrier(0)
    Unit cur, nxt; int ui = 0;
    if (!S.next(0, cur)) return;
    f32x4 acc[2][2][4][2];
#pragma unroll
    for (int a = 0; a < 2; ++a)
#pragma unroll
        for (int b = 0; b < 2; ++b)
#pragma unroll
            for (int m = 0; m < 4; ++m)
#pragma unroll
                for (int n = 0; n < 2; ++n) acc[a][b][m][n] = (f32x4){0.f, 0.f, 0.f, 0.f};
    bf16x8 At[4][2], B0[2][2], B1[2][2];
    const char* cA = (const char*)g.A + (size_t)cur.pm * tstep; const char* cB = (const char*)g.Bt + (size_t)cur.pn * tstep;
    S.a_ready(cur);
    if constexpr (SP2) {
        PG8_STAGE(PG8_SB(0, 0), cB, voffB); PG8_STAGE(PG8_SB(0, 1), cB + hstep, voffB); PG8_STAGE(PG8_SA(0, 0), cA, voffA); PG8_STAGE(PG8_SA(0, 1), cA + hstep, voffA);
        if (wr == 1) PG8_BAR;
        PG8_WAIT_V(2); PG8_BAR;
        PG8_STAGE(PG8_SB(1, 0), cB + kstep, voffB); PG8_STAGE(PG8_SA(1, 0), cA + kstep, voffA); PG8_STAGE(PG8_SB(1, 1), cB + hstep + kstep, voffB);
        PG8_WAIT_V(6); PG8_BAR;
    } else {
        PG8_STAGE(PG8_SB(0, 0), cB, voffB); PG8_STAGE(PG8_SA(0, 0), cA, voffA); PG8_STAGE(PG8_SB(0, 1), cB + hstep, voffB); PG8_STAGE(PG8_SA(0, 1), cA + hstep, voffA);
        if (wr == 1) PG8_BAR;
        PG8_WAIT_V(4); PG8_BAR;
        PG8_STAGE(PG8_SB(1, 0), cB + kstep, voffB); PG8_STAGE(PG8_SA(1, 0), cA + kstep, voffA); PG8_STAGE(PG8_SB(1, 1), cB + hstep + kstep, voffB);
        PG8_WAIT_V(6); PG8_BAR;
    }
    for (;;) {
        const bool has_next = S.next(ui + 1, nxt);
        const char* nA = has_next ? (const char*)g.A + (size_t)nxt.pm * tstep : cA; const char* nB = has_next ? (const char*)g.Bt + (size_t)nxt.pn * tstep : cB;
        for (int t = 0; t < nt; t += 2) {
            const bool last = (t == nt - 2);
            const char* a1 = cA + (size_t)(t + 1) * kstep;
            const char* a2 = last ? nA : cA + (size_t)(t + 2) * kstep; const char* b2 = last ? nB : cB + (size_t)(t + 2) * kstep;
            const char* a3 = a2 + kstep; const char* b3 = b2 + kstep;
            if (last && has_next) S.a_ready(nxt);
            if constexpr (SP2) {
            PG8_LDB(B0, 0, 0); PG8_LDB(B1, 0, 1); PG8_SCHED; PG8_LDA(At, 0, 0); PG8_STAGE(PG8_SA(1, 1), a1 + hstep, voffA);
            PG8_WAIT_V(8); PG8_WAIT_L(0); PG8_BAR; PG8_MMA(0, 0, At, B0); PG8_MMA(0, 1, At, B1); PG8_BAR; PG8_SCHED;
            PG8_LDA(At, 0, 1); PG8_STAGE(PG8_SB(0, 0), b2, voffB); PG8_STAGE(PG8_SB(0, 1), b2 + hstep, voffB); PG8_STAGE(PG8_SA(0, 0), a2, voffA);
            PG8_WAIT_V(8); PG8_WAIT_L(0); PG8_BAR; PG8_MMA(1, 0, At, B0); PG8_MMA(1, 1, At, B1); PG8_BAR; PG8_SCHED;
            PG8_LDB(B0, 1, 0); PG8_LDB(B1, 1, 1); PG8_SCHED; PG8_LDA(At, 1, 0); PG8_STAGE(PG8_SA(0, 1), a2 + hstep, voffA);
            PG8_WAIT_V(8); PG8_WAIT_L(0); PG8_BAR; PG8_MMA(0, 0, At, B0); PG8_MMA(0, 1, At, B1); PG8_BAR; PG8_SCHED;
            PG8_LDA(At, 1, 1); PG8_STAGE(PG8_SB(1, 0), b3, voffB); PG8_STAGE(PG8_SB(1, 1), b3 + hstep, voffB); PG8_STAGE(PG8_SA(1, 0), a3, voffA);
            PG8_WAIT_V(8); PG8_WAIT_L(0); PG8_BAR; PG8_MMA(1, 0, At, B0); PG8_MMA(1, 1, At, B1); PG8_BAR; PG8_SCHED;
            } else {
            PG8_LDB(B0, 0, 0); PG8_SCHED; PG8_LDA(At, 0, 0); PG8_STAGE(PG8_SA(1, 1), a1 + hstep, voffA);
            PG8_WAIT_L(8); PG8_BAR; PG8_WAIT_L(0); PG8_MMA(0, 0, At, B0); PG8_BAR; PG8_SCHED;
            PG8_LDB(B1, 0, 1); PG8_STAGE(PG8_SB(0, 0), b2, voffB);
            PG8_BAR; PG8_WAIT_L(0); PG8_MMA(0, 1, At, B1); PG8_BAR;
            PG8_LDA(At, 0, 1); PG8_STAGE(PG8_SA(0, 0), a2, voffA);
            PG8_BAR; PG8_WAIT_L(0); PG8_MMA(1, 0, At, B0); PG8_BAR; PG8_SCHED;
            PG8_STAGE(PG8_SB(0, 1), b2 + hstep, voffB);
            PG8_WAIT_V(6); PG8_BAR; PG8_MMA(1, 1, At, B1); PG8_BAR;
            PG8_LDB(B0, 1, 0); PG8_SCHED; PG8_LDA(At, 1, 0); PG8_STAGE(PG8_SA(0, 1), a2 + hstep, voffA);
            PG8_WAIT_L(8); PG8_BAR; PG8_WAIT_L(0); PG8_MMA(0, 0, At, B0); PG8_BAR; PG8_SCHED;
            PG8_LDB(B1, 1, 1); PG8_STAGE(PG8_SB(1, 0), b3, voffB);
            PG8_BAR; PG8_WAIT_L(0); PG8_MMA(0, 1, At, B1); PG8_BAR;
            PG8_LDA(At, 1, 1); PG8_STAGE(PG8_SA(1, 0), a3, voffA);
            PG8_BAR; PG8_WAIT_L(0); PG8_MMA(1, 0, At, B0); PG8_BAR; PG8_SCHED;
            PG8_STAGE(PG8_SB(1, 1), b3 + hstep, voffB);
            PG8_WAIT_V(6); PG8_BAR; PG8_MMA(1, 1, At, B1); PG8_BAR;
            }
        }
        if constexpr (ALIGN_EPI) { if (wr == 0) PG8_BAR; }
        if constexpr (!Epi::AFTER_DRAIN) { E(acc, cur, wr, wc, fr, fq); S.done(cur); }
        if (!has_next) break;
#pragma unroll
        for (int a = 0; a < 2; ++a)
#pragma unroll
            for (int b = 0; b < 2; ++b)
#pragma unroll
                for (int m = 0; m < 4; ++m)
#pragma unroll
                    for (int n = 0; n < 2; ++n) acc[a][b][m][n] = (f32x4){0.f, 0.f, 0.f, 0.f};
        cur = nxt; cA = nA; cB = nB; ++ui;
        if constexpr (ALIGN_EPI) { if (wr == 1) PG8_BAR; }
    }
    PG8_WAIT_V(0);
    if constexpr (!ALIGN_EPI) { if (wr == 0) PG8_BAR; }
    PG8_BAR;
    if constexpr (Epi::AFTER_DRAIN) { E.fused(acc, cur, wr, wc, fr, fq, lds, wid, lane); S.done(cur); }
#undef PG8_SA
#undef PG8_SB
#undef PG8_STAGE
#undef PG8_LDA
#undef PG8_LDB
#undef PG8_MMA
#undef PG8_WAIT_V
#undef PG8_WAIT_L
#undef PG8_BAR
#undef PG8_SCHED
}
}
#define GAS __attribute__((address_space(1)))
#define LAS __attribute__((address_space(3)))
typedef unsigned short bf16;
typedef unsigned v4u __attribute__((ext_vector_type(4)));
typedef unsigned v2u __attribute__((ext_vector_type(2)));
typedef float f32x4 __attribute__((ext_vector_type(4)));
typedef short bf16x8 __attribute__((ext_vector_type(8)));
typedef float f32x16 __attribute__((ext_vector_type(16)));

constexpr int D_MODEL = 1024, BATCH = 8, SEQ = 2048, M = BATCH * SEQ;
constexpr int D_IN = 2312, NPROJ = 2304, D_FF = 2816;
constexpr int PZ = 0, PX = 512, PB = 1024, PC = 1280, PQ = 1536, PK = 2048, PV = 2176;
constexpr int W_IN_DT = 1536;
constexpr float EPS = 1e-5f;
constexpr size_t MiB = 1u << 20;
constexpr size_t WS_DTRAW = MiB / 2, WS_DTV = 1 * MiB, WS_ACUM = 3 * MiB / 2, WS_RS1 = 2 * MiB, WS_SS2 = 2 * MiB + 256 * 1024, WS_SS3 = 2 * MiB + 512 * 1024, WS_ALAST = 2 * MiB + 768 * 1024;
constexpr size_t WS_WIN = 4 * MiB, WS_WO = 9 * MiB, WS_WGU = 11 * MiB, WS_WD = 22 * MiB;
constexpr size_t WS_XB = 28 * MiB, WS_YMIX = 28 * MiB;
constexpr size_t WS_PROJ = 60 * MiB, WS_XC = 132 * MiB, WS_STATES = 164 * MiB, WS_HPREV = 196 * MiB;
constexpr size_t WS_X2 = 60 * MiB, WS_X2B = 124 * MiB, WS_ACT = 156 * MiB;
static_assert(WS_ACT + (size_t)M * D_FF * 2 <= 256 * MiB, "ws map");
constexpr int LDS_BYTES = 155648;
constexpr int NWAVES = 8;

__device__ __forceinline__ float bf2f(unsigned short b) { return __uint_as_float(((unsigned)b) << 16); }
__device__ __forceinline__ unsigned f2bf(float f) { unsigned u = __float_as_uint(f); return (u + 0x7fffu + ((u >> 16) & 1u)) >> 16; }
__device__ __forceinline__ unsigned pk2(float lo, float hi) { return f2bf(lo) | (f2bf(hi) << 16); }
__device__ __forceinline__ float silu_f(float v) { return v / (1.f + __expf(-v)); }
__device__ __forceinline__ float softplus_f(float v) { return v > 20.f ? v : log1pf(__expf(v)); }
__device__ __forceinline__ float wave_sum(float v) {
#pragma unroll
    for (int o = 1; o < 64; o <<= 1) v += __shfl_xor(v, o);
    return v;
}
#define LDS_WAIT() asm volatile("s_waitcnt lgkmcnt(0)" ::: "memory")

__device__ __forceinline__ void p0_transpose_item(const float* W, int ldw, int col_off, int K, const float* kscale, bf16* WT, int mode, int row_off, int nblk, LAS float* scr, int item, int lane) {
    const int kb = item / nblk, nb = item % nblk, k0 = 64 * kb, n0 = 32 * nb;
#pragma unroll 8
    for (int i = 0; i < 32; ++i) { const int kk = 2 * i + (lane >> 5); float v = W[(size_t)(k0 + kk) * ldw + col_off + n0 + (lane & 31)]; if (kscale) v *= kscale[k0 + kk]; scr[kk * 33 + (lane & 31)] = v; }
    LDS_WAIT();
    const int c = lane & 7;
#pragma unroll
    for (int j = 0; j < 4; ++j) { const int n = (lane >> 3) + 8 * j; const LAS float* s = scr + (8 * c) * 33 + n;
        v4u o; o.x = pk2(s[0 * 33], s[1 * 33]); o.y = pk2(s[2 * 33], s[3 * 33]); o.z = pk2(s[4 * 33], s[5 * 33]); o.w = pk2(s[6 * 33], s[7 * 33]);
        const int nn = n0 + n; const int drow = mode == 0 ? row_off + nn : 256 * (nn >> 7) + (nn & 127) + row_off;
        *(v4u*)(WT + (size_t)drow * K + k0 + 8 * c) = o; }
    LDS_WAIT();
}

typedef float f32x2_t __attribute__((ext_vector_type(2))); typedef __bf16 bf16x2_t __attribute__((ext_vector_type(2)));
__device__ __forceinline__ unsigned cvtpk(float lo, float hi) { f32x2_t v = {lo, hi}; bf16x2_t b = __builtin_convertvector(v, bf16x2_t); return __builtin_bit_cast(unsigned, b); }
__device__ __forceinline__ int crow(int i, int h) { return (i & 3) + 8 * (i >> 2) + 4 * h; }
#define MFMA32(a, b, c) __builtin_amdgcn_mfma_f32_32x32x16_bf16((a), (b), (c), 0, 0, 0)
#define PACK_STEP(x, s) __builtin_bit_cast(bf16x8, (v4u){cvtpk((x)[8 * (s)], (x)[8 * (s) + 1]), cvtpk((x)[8 * (s) + 2], (x)[8 * (s) + 3]), cvtpk((x)[8 * (s) + 4], (x)[8 * (s) + 5]), cvtpk((x)[8 * (s) + 6], (x)[8 * (s) + 7])})
__device__ __forceinline__ bf16x8 lds_frag_perm(const LAS bf16* p) { const v2u lo = *(const LAS v2u*)p, hi = *(const LAS v2u*)(p + 8); return __builtin_bit_cast(bf16x8, (v4u){lo.x, lo.y, hi.x, hi.y}); }

constexpr int AT_KS = 72, AT_VS = 264;
constexpr int AT_VT_OFF = 256 * AT_KS * 2;
__device__ __forceinline__ void attn_phase(LAS unsigned char* lds, const bf16* proj, const float* sinks, bf16* ymix, int G, int bx, int tid, int lane, int wave) {
    LAS bf16* Ks = (LAS bf16*)lds;
    LAS bf16* Vt = (LAS bf16*)(lds + AT_VT_OFF);
    const int r = lane & 31, h = lane >> 5;
    const float LOG2E = 1.4426950408889634f, SC2 = 0.125f * LOG2E;
    for (int item = bx; item < 256; item += G) {
        const int kvh = item & 1, qb = (item >> 1) & 15, b = item >> 5;
        const int m0 = b * SEQ + qb * 128;
        __syncthreads();
#pragma unroll
        for (int i = 0; i < 4; ++i) { const int c = tid + 512 * i, row = c >> 3, ch = c & 7; v4u val = (v4u){0u, 0u, 0u, 0u};
            if (qb > 0 || row >= 128) val = *(const v4u*)(proj + (size_t)(m0 - 128 + row) * NPROJ + PK + kvh * 64 + ch * 8);
            *(LAS v4u*)(Ks + row * AT_KS + ch * 8) = val; }
#pragma unroll
        for (int i = 0; i < 2; ++i) { const int c = tid + 512 * i, kp = c & 127, ch = c >> 7; v4u va = (v4u){0u, 0u, 0u, 0u}, vb = va;
            if (qb > 0 || kp >= 64) { const bf16* src = proj + (size_t)(m0 - 128 + 2 * kp) * NPROJ + PV + kvh * 64 + ch * 8; va = *(const v4u*)src; vb = *(const v4u*)(src + NPROJ); }
#pragma unroll
            for (int e = 0; e < 8; ++e) { const unsigned lo = (va[e >> 1] >> (16 * (e & 1))) & 0xffffu, hi = (vb[e >> 1] >> (16 * (e & 1))) & 0xffffu;
                *(LAS unsigned*)(Vt + (ch * 8 + e) * AT_VS + 2 * kp) = lo | (hi << 16); } }
        __syncthreads();
        const int hq = kvh * 4 + (wave >> 1);
        const float sink2 = sinks[hq] * LOG2E;
        for (int jj = 0; jj < 2; ++jj) {
            const int j = 2 * (wave & 1) + jj;
            const size_t qrow = (size_t)(m0 + 32 * j + r);
            bf16x8 qf[4];
#pragma unroll
            for (int ks = 0; ks < 4; ++ks) qf[ks] = *(const bf16x8*)(proj + qrow * NPROJ + PQ + hq * 64 + 16 * ks + 8 * h);
            f32x16 s[5];
#pragma unroll
            for (int kb = 0; kb < 5; ++kb) {
#pragma unroll
                for (int i = 0; i < 16; ++i) s[kb][i] = 0.f;
#pragma unroll
                for (int ks = 0; ks < 4; ++ks) { const bf16x8 a = *(const LAS bf16x8*)(Ks + (32 * (j + kb) + r) * AT_KS + 16 * ks + 8 * h); s[kb] = MFMA32(a, qf[ks], s[kb]); }
            }
            const int qp = 128 + 32 * j + r;
            float mx = sink2;
#pragma unroll
            for (int kb = 0; kb < 5; ++kb)
#pragma unroll
                for (int i = 0; i < 16; ++i) { const int kp = 32 * (j + kb) + crow(i, h);
                    const bool valid = (kp <= qp) && (kp > qp - 128) && (qb > 0 || kp >= 128);
                    const float t = valid ? s[kb][i] * SC2 : -INFINITY; s[kb][i] = t; mx = fmaxf(mx, t); }
            mx = fmaxf(mx, __shfl_xor(mx, 32));
            float sum = 0.f;
#pragma unroll
            for (int kb = 0; kb < 5; ++kb)
#pragma unroll
                for (int i = 0; i < 16; ++i) { const float p = __builtin_amdgcn_exp2f(s[kb][i] - mx); s[kb][i] = p; sum += p; }
            sum += __shfl_xor(sum, 32);
            sum += __builtin_amdgcn_exp2f(sink2 - mx);
            const float inv = 1.f / sum;
            f32x16 o[2];
#pragma unroll
            for (int db = 0; db < 2; ++db)
#pragma unroll
                for (int i = 0; i < 16; ++i) o[db][i] = 0.f;
#pragma unroll
            for (int kb = 0; kb < 5; ++kb)
#pragma unroll
                for (int st = 0; st < 2; ++st) { const bf16x8 pb = PACK_STEP(s[kb], st);
#pragma unroll
                    for (int db = 0; db < 2; ++db) { const bf16x8 a = lds_frag_perm(Vt + (32 * db + r) * AT_VS + 32 * (j + kb) + 16 * st + 4 * h); o[db] = MFMA32(a, pb, o[db]); } }
            bf16* orow = ymix + qrow * 1024 + 512 + hq * 64;
#pragma unroll
            for (int db = 0; db < 2; ++db)
#pragma unroll
                for (int g = 0; g < 4; ++g) { v2u w; w.x = cvtpk(o[db][4 * g] * inv, o[db][4 * g + 1] * inv); w.y = cvtpk(o[db][4 * g + 2] * inv, o[db][4 * g + 3] * inv);
                    *(v2u*)(orow + 32 * db + 8 * g + 4 * h) = w; }
        }
    }
    __syncthreads();
}
typedef short v4i16_t __attribute__((ext_vector_type(4)));
__device__ __forceinline__ v2u tr_read(const LAS bf16* p) { return __builtin_bit_cast(v2u, __builtin_amdgcn_ds_read_tr16_b64_v4i16((LAS v4i16_t*)p)); }
__device__ __forceinline__ bf16x8 tr_frag(const LAS bf16* img, int RS, int klo, int khi, int c0, int lane) {
    const int i16 = lane & 15, q = i16 >> 2, p = i16 & 3, blk = (lane >> 4) & 1;
    const v2u lo = tr_read(img + (klo + q) * RS + c0 + 16 * blk + 4 * p), hi = tr_read(img + (khi + q) * RS + c0 + 16 * blk + 4 * p);
    return __builtin_bit_cast(bf16x8, (v4u){lo.x, lo.y, hi.x, hi.y});
}

constexpr int SA_XS = 288, SA_BS = 160;
constexpr int SA_B_OFF = 128 * SA_XS * 2, SA_S_OFF = SA_B_OFF + 128 * SA_BS * 2;
__device__ __forceinline__ void ssd_a_phase(LAS unsigned char* lds, const bf16* proj, const float* dtraw, const float* conv_w, const float* conv_b, const float* dt_bias, const float* a_log,
                                            bf16* xc, float* dtv, float* acum, float* alast, float* states, int G, int bx, int tid, int lane, int wave) {
    LAS bf16* Xs = (LAS bf16*)lds; LAS bf16* Bs = (LAS bf16*)(lds + SA_B_OFF);
    LAS float* dts = (LAS float*)(lds + SA_S_OFF); LAS float* acs = dts + 512; LAS float* tot = acs + 512;
    const int r = lane & 31, h = lane >> 5;
    for (int item = bx; item < 256; item += G) {
        const int g = item & 1, c = (item >> 1) & 15, b = item >> 5, m0 = b * SEQ + c * 128;
        __syncthreads();
        {
            const int hl = tid >> 7, t = tid & 127, hd = 4 * g + hl; const size_t m = (size_t)(m0 + t);
            const float dt = softplus_f(dtraw[m * 8 + hd] + dt_bias[hd]);
            float v = dt * (-__expf(a_log[hd]));
#pragma unroll
            for (int o = 1; o < 64; o <<= 1) { const float n = __shfl_up(v, o); if (lane >= o) v += n; }
            if (lane == 63) tot[wave] = v;
            __syncthreads();
            if (wave & 1) v += tot[wave - 1];
            dts[tid] = dt; acs[tid] = v; dtv[m * 8 + hd] = dt; acum[m * 8 + hd] = v;
            if (t == 127) alast[(b * 16 + c) * 8 + hd] = v;
            __syncthreads();
        }
        {
            const int cgk = lane, ts = wave;
            const int scol = cgk < 32 ? PX + 256 * g + 8 * cgk : (cgk < 48 ? PB + 128 * g + 8 * (cgk - 32) : PC + 128 * g + 8 * (cgk - 48));
            const int dcol = cgk < 32 ? 256 * g + 8 * cgk : (cgk < 48 ? 512 + 128 * g + 8 * (cgk - 32) : 768 + 128 * g + 8 * (cgk - 48));
            float w[4][8], bias[8];
#pragma unroll
            for (int k = 0; k < 4; ++k) { const f32x4 a = *(const f32x4*)(conv_w + k * 1024 + dcol), bq = *(const f32x4*)(conv_w + k * 1024 + dcol + 4);
                w[k][0] = a.x; w[k][1] = a.y; w[k][2] = a.z; w[k][3] = a.w; w[k][4] = bq.x; w[k][5] = bq.y; w[k][6] = bq.z; w[k][7] = bq.w; }
            { const f32x4 a = *(const f32x4*)(conv_b + dcol), bq = *(const f32x4*)(conv_b + dcol + 4);
                bias[0] = a.x; bias[1] = a.y; bias[2] = a.z; bias[3] = a.w; bias[4] = bq.x; bias[5] = bq.y; bias[6] = bq.z; bias[7] = bq.w; }
            const int hl = (cgk >> 3) & 3; const float al = acs[hl * 128 + 127];
            float win[4][8];
#pragma unroll
            for (int tt = 0; tt < 19; ++tt) {
                const int trow = 16 * ts - 3 + tt;
                v4u raw = (v4u){0u, 0u, 0u, 0u};
                if (c * 128 + trow >= 0) raw = *(const v4u*)(proj + (size_t)(m0 + trow) * NPROJ + scol);
#pragma unroll
                for (int e = 0; e < 4; ++e) { win[tt & 3][2 * e] = __uint_as_float(raw[e] << 16); win[tt & 3][2 * e + 1] = __uint_as_float(raw[e] & 0xffff0000u); }
                if (tt >= 3) {
                    float o[8];
#pragma unroll
                    for (int e = 0; e < 8; ++e) { float a = bias[e];
#pragma unroll
                        for (int k = 0; k < 4; ++k) a += w[k][e] * win[(tt - 3 + k) & 3][e];
                        o[e] = silu_f(a); }
                    *(v4u*)(xc + (size_t)(m0 + trow) * 1024 + dcol) = (v4u){cvtpk(o[0], o[1]), cvtpk(o[2], o[3]), cvtpk(o[4], o[5]), cvtpk(o[6], o[7])};
                    if (cgk < 32) { const float sc = dts[hl * 128 + trow] * __expf(al - acs[hl * 128 + trow]);
                        *(LAS v4u*)(Xs + trow * SA_XS + 8 * cgk) = (v4u){cvtpk(o[0] * sc, o[1] * sc), cvtpk(o[2] * sc, o[3] * sc), cvtpk(o[4] * sc, o[5] * sc), cvtpk(o[6] * sc, o[7] * sc)}; }
                    else if (cgk < 48) *(LAS v4u*)(Bs + trow * SA_BS + 8 * (cgk - 32)) = (v4u){cvtpk(o[0], o[1]), cvtpk(o[2], o[3]), cvtpk(o[4], o[5]), cvtpk(o[6], o[7])};
                }
            }
        }
        __syncthreads();
        {
            const int hl = wave >> 1, pb = wave & 1, c0 = hl * 64 + pb * 32;
            f32x16 acc[4];
#pragma unroll
            for (int nb = 0; nb < 4; ++nb)
#pragma unroll
                for (int i = 0; i < 16; ++i) acc[nb][i] = 0.f;
#pragma unroll
            for (int ks = 0; ks < 8; ++ks) { const int k0 = 16 * ks; const bf16x8 a = tr_frag(Xs, SA_XS, k0 + 8 * h, k0 + 8 * h + 4, c0, lane);
#pragma unroll
                for (int nb = 0; nb < 4; ++nb) { const bf16x8 bb = tr_frag(Bs, SA_BS, k0 + 8 * h, k0 + 8 * h + 4, 32 * nb, lane); acc[nb] = MFMA32(a, bb, acc[nb]); } }
            float* dst = states + ((size_t)((b * 16 + c) * 8 + 4 * g + hl) * 64 + 32 * pb) * 128;
#pragma unroll
            for (int nb = 0; nb < 4; ++nb)
#pragma unroll
                for (int i = 0; i < 16; ++i) dst[crow(i, h) * 128 + 32 * nb + r] = acc[nb][i];
        }
    }
    __syncthreads();
}

__device__ __forceinline__ void ssd_scan_phase(const float* states, const float* alast, bf16* hprev, int G, int bx, int tid) {
    for (int e = bx * (NWAVES * 64) + tid; e < 8 * 8 * 64 * 32; e += G * NWAVES * 64) {
        const int n4 = e & 31, p = (e >> 5) & 63, hd = (e >> 11) & 7, b = e >> 14;
        f32x4 st = (f32x4){0.f, 0.f, 0.f, 0.f};
#pragma unroll 4
        for (int c = 0; c < 16; ++c) { const size_t idx = ((size_t)((b * 16 + c) * 8 + hd) * 64 + p) * 128 + 4 * n4;
            *(v2u*)(hprev + idx) = (v2u){cvtpk(st.x, st.y), cvtpk(st.z, st.w)};
            const float dec = __expf(alast[(b * 16 + c) * 8 + hd]);
            st = st * dec + *(const f32x4*)(states + idx); }
    }
}

constexpr int SB_BS = 136, SB_XS = 288, SB_YS = 260;
constexpr int SB_C_OFF = 128 * SB_BS * 2, SB_X_OFF = 2 * SB_C_OFF, SB_S_OFF = SB_X_OFF + 128 * SB_XS * 2;
__device__ __forceinline__ void ssd_b_phase(LAS unsigned char* lds, const bf16* proj, const bf16* xc, const float* dtv, const float* acum, const bf16* hprev, const float* d_skip, const float* nw,
                                            float* ytmp, bf16* ymix, int G, int bx, int tid, int lane, int wave) {
    LAS bf16* Bs = (LAS bf16*)lds; LAS bf16* Cs = (LAS bf16*)(lds + SB_C_OFF); LAS bf16* Xs = (LAS bf16*)(lds + SB_X_OFF);
    LAS float* dts = (LAS float*)(lds + SB_S_OFF); LAS float* acs = dts + 512; LAS float* ssp = acs + 512;
    const int r = lane & 31, h = lane >> 5;
    for (int item = bx; item < 256; item += G) {
        const int g = item & 1, c = (item >> 1) & 15, b = item >> 5, m0 = b * SEQ + c * 128;
        __syncthreads();
#pragma unroll
        for (int i = 0; i < 4; ++i) { const int idx = tid + 512 * i, row = idx >> 4, ch = idx & 15; const bf16* src = xc + (size_t)(m0 + row) * 1024 + 128 * g + 8 * ch;
            *(LAS v4u*)(Bs + row * SB_BS + 8 * ch) = *(const v4u*)(src + 512); *(LAS v4u*)(Cs + row * SB_BS + 8 * ch) = *(const v4u*)(src + 768); }
#pragma unroll
        for (int i = 0; i < 8; ++i) { const int idx = tid + 512 * i, row = idx >> 5, ch = idx & 31; *(LAS v4u*)(Xs + row * SB_XS + 8 * ch) = *(const v4u*)(xc + (size_t)(m0 + row) * 1024 + 256 * g + 8 * ch); }
        { const int hl = tid >> 7, t = tid & 127; dts[tid] = dtv[(size_t)(m0 + t) * 8 + 4 * g + hl]; acs[tid] = acum[(size_t)(m0 + t) * 8 + 4 * g + hl]; }
        __syncthreads();
        const int tb = wave & 3, hp = wave >> 2, t = 32 * tb + r;
        const size_t mt = (size_t)(m0 + t);
        float ssq = 0.f;
#pragma unroll 1
        for (int hh = 0; hh < 2; ++hh) {
            f32x16 yacc[2];
            const int hl = 2 * hp + hh, hd = 4 * g + hl;
            const float act = acs[hl * 128 + t], ea = __expf(act), dsk = d_skip[hd];
#pragma unroll
            for (int pb = 0; pb < 2; ++pb) {
#pragma unroll
                for (int i = 0; i < 16; ++i) yacc[pb][i] = 0.f;
                if (c > 0) { const bf16* hp0 = hprev + ((size_t)((b * 16 + c) * 8 + hd) * 64 + 32 * pb + r) * 128 + 8 * h;
#pragma unroll
                    for (int ks = 0; ks < 8; ++ks) { const bf16x8 a = *(const bf16x8*)(hp0 + 16 * ks), bb = *(const LAS bf16x8*)(Cs + t * SB_BS + 16 * ks + 8 * h); yacc[pb] = MFMA32(a, bb, yacc[pb]); }
#pragma unroll
                    for (int i = 0; i < 16; ++i) yacc[pb][i] *= ea; }
            }
#pragma unroll
            for (int sb = 0; sb < 4; ++sb) if (sb <= tb) {
                f32x16 L;
#pragma unroll
                for (int i = 0; i < 16; ++i) L[i] = 0.f;
#pragma unroll
                for (int ks = 0; ks < 8; ++ks) { const bf16x8 a = *(const LAS bf16x8*)(Bs + (32 * sb + r) * SB_BS + 16 * ks + 8 * h), bb = *(const LAS bf16x8*)(Cs + t * SB_BS + 16 * ks + 8 * h);
                    L = MFMA32(a, bb, L); }
#pragma unroll
                for (int i = 0; i < 16; ++i) { const int s = 32 * sb + crow(i, h); const float v = L[i] * __expf(act - acs[hl * 128 + s]) * dts[hl * 128 + s]; L[i] = (s <= t) ? v : 0.f; }
#pragma unroll
                for (int st = 0; st < 2; ++st) { const bf16x8 pk = PACK_STEP(L, st);
#pragma unroll
                    for (int pb = 0; pb < 2; ++pb) { const bf16x8 a = tr_frag(Xs, SB_XS, 32 * sb + 16 * st + 4 * h, 32 * sb + 16 * st + 8 + 4 * h, hl * 64 + 32 * pb, lane); yacc[pb] = MFMA32(a, pk, yacc[pb]); } }
                asm volatile("" ::: "memory");
            }
#pragma unroll
            for (int pb = 0; pb < 2; ++pb)
#pragma unroll
                for (int q = 0; q < 4; ++q) { const int ch = hl * 64 + 32 * pb + 8 * q + 4 * h;
                    const v2u xv = *(const LAS v2u*)(Xs + t * SB_XS + ch); const v2u zr = *(const v2u*)(proj + mt * NPROJ + PZ + 256 * g + ch);
                    const float v0 = (yacc[pb][4 * q] + dsk * __uint_as_float(xv.x << 16)) * silu_f(__uint_as_float(zr.x << 16));
                    const float v1 = (yacc[pb][4 * q + 1] + dsk * __uint_as_float(xv.x & 0xffff0000u)) * silu_f(__uint_as_float(zr.x & 0xffff0000u));
                    const float v2 = (yacc[pb][4 * q + 2] + dsk * __uint_as_float(xv.y << 16)) * silu_f(__uint_as_float(zr.y << 16));
                    const float v3 = (yacc[pb][4 * q + 3] + dsk * __uint_as_float(xv.y & 0xffff0000u)) * silu_f(__uint_as_float(zr.y & 0xffff0000u));
                    *(f32x4*)(ytmp + mt * 512 + 256 * g + ch) = (f32x4){v0, v1, v2, v3};
                    ssq += (v0 * v0 + v1 * v1) + (v2 * v2 + v3 * v3); }
            asm volatile("" ::: "memory");
        }
        ssq += __shfl_xor(ssq, 32);
        if (h == 0) ssp[hp * 128 + t] = ssq;
        __syncthreads();
        const float rs = rsqrtf((ssp[t] + ssp[128 + t]) * (1.f / 256.f) + EPS);
#pragma unroll
        for (int hh = 0; hh < 2; ++hh)
#pragma unroll
            for (int pb = 0; pb < 2; ++pb)
#pragma unroll
                for (int q = 0; q < 4; ++q) { const int ch = 256 * g + (2 * hp + hh) * 64 + 32 * pb + 8 * q + 4 * h; const f32x4 wv = *(const f32x4*)(nw + ch); const f32x4 v = *(const f32x4*)(ytmp + mt * 512 + ch);
                    *(v2u*)(ymix + mt * 1024 + ch) = (v2u){cvtpk(v.x * rs * wv.x, v.y * rs * wv.y), cvtpk(v.z * rs * wv.z, v.w * rs * wv.w)}; }
    }
    __syncthreads();
}

#define XB_TMO      128
#define XB_XCNT(j)  (256  + 64 * (j))
#define XB_XSUB(j)  (1280 + 64 * (j))
#define XB_XGEN(j)  (2304 + 64 * (j))
#define XB_TOP      3328
#define XB_TOPGEN   3392
#define XCD_BAR_WORDS 3456
#define XB_SPIN_CAP (1u << 18)

__device__ __forceinline__ unsigned xb_ld(unsigned* p)              { return __hip_atomic_load(p, __ATOMIC_RELAXED, __HIP_MEMORY_SCOPE_AGENT); }
__device__ __forceinline__ unsigned xb_add(unsigned* p, unsigned v) { return __hip_atomic_fetch_add(p, v, __ATOMIC_RELAXED, __HIP_MEMORY_SCOPE_AGENT); }
__device__ __forceinline__ unsigned xb_xcc_id() { return (unsigned)__builtin_amdgcn_s_getreg((3 << 11) | 20) & 0xFu; }
#define XB_SPIN(cond, bar) do { unsigned _sp = 0; while (cond) { __builtin_amdgcn_s_sleep(1); \
    if ((++_sp & 255u) == 0u) { if (xb_ld(&(bar)[XB_TMO])) break; if (_sp > XB_SPIN_CAP) { atomicAdd(&(bar)[XB_TMO], 1u); break; } } } } while (0)

struct XcdBarrier {
    unsigned* bar; unsigned x;
    volatile LAS unsigned* st;
};

__device__ __forceinline__ XcdBarrier xcd_barrier_post(unsigned* bar, volatile LAS unsigned* st) {
    XcdBarrier b; b.bar = bar; b.x = xb_xcc_id(); b.st = st;
    if (threadIdx.x == 0) (void)xb_add(&bar[XB_XCNT(b.x)], 1u);
    return b;
}
__device__ __forceinline__ void xcd_barrier_complete(unsigned* bar, unsigned x, unsigned& nloc, unsigned& nx) {
    const unsigned G = gridDim.x * gridDim.y * gridDim.z;
    unsigned sum, cnt, mine, sp = 0u;
    for (;;) {
        sum = 0u; cnt = 0u; mine = 0u;
#pragma unroll
        for (unsigned j = 0; j < 16; ++j) { const unsigned c = xb_ld(&bar[XB_XCNT(j)]); sum += c; cnt += (c > 0u) ? 1u : 0u; mine = (j == x) ? c : mine; }
        if (sum == G) break;
        __builtin_amdgcn_s_sleep(1);
        if ((++sp & 255u) == 0u) { if (xb_ld(&bar[XB_TMO])) break; if (sp > XB_SPIN_CAP) { atomicAdd(&bar[XB_TMO], 1u); break; } }
    }
    nloc = mine > 0u ? mine : 1u; nx = cnt > 0u ? cnt : 1u;
}

__device__ __forceinline__ void xcd_barrier(const XcdBarrier& b) {
    asm volatile("s_waitcnt vmcnt(0)" ::: "memory");
    __syncthreads();
    if (threadIdx.x == 0) {
        unsigned* bar = b.bar;
        __builtin_amdgcn_s_waitcnt(0);
        unsigned nloc = b.st[0], nx = b.st[1];
        if (nloc == 0u) { xcd_barrier_complete(bar, b.x, nloc, nx); b.st[0] = nloc; b.st[1] = nx; }
        const unsigned old = xb_add(&bar[XB_XSUB(b.x)], 1u);
        const unsigned gen = old / nloc;
        if (old + 1u == (gen + 1u) * nloc) {
            __builtin_amdgcn_fence(__ATOMIC_RELEASE, "agent");
            asm volatile("s_waitcnt vmcnt(0)" ::: "memory");
            const unsigned og = xb_add(&bar[XB_TOP], 1u);
            const unsigned tg = og / nx;
            if (og + 1u == (tg + 1u) * nx) xb_add(&bar[XB_TOPGEN], 1u);
            else XB_SPIN(xb_ld(&bar[XB_TOPGEN]) == tg, bar);
            __builtin_amdgcn_fence(__ATOMIC_ACQUIRE, "agent");
            xb_add(&bar[XB_XGEN(b.x)], 1u);
            asm volatile("s_waitcnt vmcnt(0)" ::: "memory");
        } else {
            XB_SPIN(xb_ld(&bar[XB_XGEN(b.x)]) == gen, bar);
            __builtin_amdgcn_fence(__ATOMIC_ACQUIRE, "agent");
            asm volatile("s_waitcnt vmcnt(0)" ::: "memory");
        }
    }
    __syncthreads();
}

#ifndef REP2
#define REP2 1
#endif
#ifndef REP3
#define REP3 1
#endif
#ifndef REP4
#define REP4 1
#endif
#ifndef XSYNC
#define XSYNC 0
#endif
struct Args { const float* in[16]; float* out; unsigned char* ws; int phmask; int pad; };

__global__ void __launch_bounds__(NWAVES * 64, 2) mega_fwd(Args args) {
    extern __shared__ __attribute__((aligned(16))) unsigned char lds_raw[];
    cg::grid_group grid = cg::this_grid();
    LAS unsigned char* lds = (LAS unsigned char*)lds_raw;
    const int tid = threadIdx.x, lane = tid & 63, wave = __builtin_amdgcn_readfirstlane(tid >> 6);
    const int G = gridDim.x, bx = blockIdx.x;
    const int phmask = args.phmask;
    unsigned char* ws = args.ws;
    volatile LAS unsigned* MISC = (volatile LAS unsigned*)(lds + LDS_BYTES - 64);
    if (tid < 16) MISC[tid] = 0u;
    __syncthreads();
    XcdBarrier xbar = xcd_barrier_post((unsigned*)ws, MISC);
    const float* x = args.in[0]; const float* norm_mix_w = args.in[1]; const float* w_in = args.in[2];
    const float* w_out = args.in[10]; const float* norm_ffn_w = args.in[11];
    const float* w_gate = args.in[12]; const float* w_up = args.in[13]; const float* w_down = args.in[14]; const float* norm_final_w = args.in[15];
    bf16* WinT = (bf16*)(ws + WS_WIN); bf16* WoT = (bf16*)(ws + WS_WO); bf16* WguT = (bf16*)(ws + WS_WGU); bf16* WdT = (bf16*)(ws + WS_WD);
    bf16* xb = (bf16*)(ws + WS_XB); bf16* ymix = (bf16*)(ws + WS_YMIX); bf16* proj = (bf16*)(ws + WS_PROJ);
    float* dtraw = (float*)(ws + WS_DTRAW); float* rs1 = (float*)(ws + WS_RS1); float* ss2 = (float*)(ws + WS_SS2); float* ss3 = (float*)(ws + WS_SS3);
    bf16* xc = (bf16*)(ws + WS_XC); float* states = (float*)(ws + WS_STATES); bf16* hprev = (bf16*)(ws + WS_HPREV);
    float* dtv = (float*)(ws + WS_DTV); float* acum = (float*)(ws + WS_ACUM); float* alast = (float*)(ws + WS_ALAST);
    float* x2 = (float*)(ws + WS_X2); bf16* x2b = (bf16*)(ws + WS_X2B); bf16* act = (bf16*)(ws + WS_ACT);
#define PH(k) (phmask & (1 << (k)))
#define SEAM(k) do { if (phmask >> ((k) + 1)) { if ((k) == 0) grid.sync(); else xcd_barrier(xbar); } } while (0)

    if (PH(0)) {
        const int gw = bx * NWAVES + wave, NGW = G * NWAVES;
        LAS float* wdt = (LAS float*)(lds + 8 * 8704);
        for (int idx = tid; idx < 1024 * 8; idx += NWAVES * 64) { const int k = idx >> 3, j = idx & 7; wdt[idx] = w_in[(size_t)k * D_IN + W_IN_DT + j] * norm_mix_w[k]; }
        __syncthreads();
        for (int m = gw; m < M; m += NGW) {
            const f32x4* xr = (const f32x4*)(x + (size_t)m * D_MODEL) + lane;
            f32x4 v[4]; float s = 0.f;
#pragma unroll
            for (int j = 0; j < 4; ++j) { v[j] = xr[64 * j]; s += (v[j].x * v[j].x + v[j].y * v[j].y) + (v[j].z * v[j].z + v[j].w * v[j].w); }
            const float rs = rsqrtf(wave_sum(s) * (1.f / D_MODEL) + EPS);
            unsigned long long* o8 = (unsigned long long*)(xb + (size_t)m * D_MODEL) + lane;
#pragma unroll
            for (int j = 0; j < 4; ++j) o8[64 * j] = (unsigned long long)pk2(v[j].x, v[j].y) | ((unsigned long long)pk2(v[j].z, v[j].w) << 32);
            float d[8];
#pragma unroll
            for (int q = 0; q < 8; ++q) d[q] = 0.f;
#pragma unroll
            for (int j = 0; j < 4; ++j)
#pragma unroll
                for (int i = 0; i < 4; ++i) { const int k = 4 * (lane + 64 * j) + i; const float xv = v[j][i];
                    const f32x4 wa = *(const LAS f32x4*)(wdt + k * 8), wb = *(const LAS f32x4*)(wdt + k * 8 + 4);
                    d[0] += xv * wa.x; d[1] += xv * wa.y; d[2] += xv * wa.z; d[3] += xv * wa.w; d[4] += xv * wb.x; d[5] += xv * wb.y; d[6] += xv * wb.z; d[7] += xv * wb.w; }
#pragma unroll
            for (int q = 0; q < 8; ++q) d[q] = wave_sum(d[q]);
            if (lane == 0) { rs1[m] = rs;
                *(f32x4*)(dtraw + (size_t)m * 8) = (f32x4){d[0] * rs, d[1] * rs, d[2] * rs, d[3] * rs}; *(f32x4*)(dtraw + (size_t)m * 8 + 4) = (f32x4){d[4] * rs, d[5] * rs, d[6] * rs, d[7] * rs}; }
        }
        LAS float* scr = (LAS float*)(lds + wave * 8704);
        constexpr int I_IN1 = 16 * 48, I_IN2 = 16 * 24, I_O = 16 * 32, I_G = 16 * 88, I_D = 44 * 32;
        constexpr int NITEMS = I_IN1 + I_IN2 + I_O + 2 * I_G + I_D;
        for (int it = gw; it < NITEMS; it += NGW) {
            int r = it;
            if (r < I_IN1) { p0_transpose_item(w_in, D_IN, 0, 1024, norm_mix_w, WinT, 0, 0, 48, scr, r, lane); continue; } r -= I_IN1;
            if (r < I_IN2) { p0_transpose_item(w_in, D_IN, 1544, 1024, norm_mix_w, WinT, 0, 1536, 24, scr, r, lane); continue; } r -= I_IN2;
            if (r < I_O) { p0_transpose_item(w_out, 1024, 0, 1024, nullptr, WoT, 0, 0, 32, scr, r, lane); continue; } r -= I_O;
            if (r < I_G) { p0_transpose_item(w_gate, D_FF, 0, 1024, norm_ffn_w, WguT, 1, 0, 88, scr, r, lane); continue; } r -= I_G;
            if (r < I_G) { p0_transpose_item(w_up, D_FF, 0, 1024, norm_ffn_w, WguT, 1, 128, 88, scr, r, lane); continue; } r -= I_G;
            p0_transpose_item(w_down, 1024, 0, D_FF, nullptr, WdT, 0, 0, 32, scr, r, lane);
        }
        __syncthreads();
        SEAM(0);
    }
    if (PH(1)) {
        pg8::Gemm g{xb, WinT, M, NPROJ, 1024}; pg8::StaticOrder S; S.init(M, NPROJ, G, bx);
        pg8::EpiRS E{proj, NPROJ, rs1};
        pg8::gemm_phase<pg8::EpiRS, pg8::StaticOrder, true, true>(lds, g, S, E);
        SEAM(1);
    }
    if (PH(2)) {
        for (int rep = 0; rep < REP2; ++rep) {
        attn_phase(lds, proj, args.in[9], ymix, G, bx, tid, lane, wave);
        ssd_a_phase(lds, proj, dtraw, args.in[3], args.in[4], args.in[5], args.in[6], xc, dtv, acum, alast, states, G, bx, tid, lane, wave);
        SEAM(2); }
        for (int rep = 0; rep < XSYNC; ++rep) grid.sync();
    }
    if (PH(3)) {
        for (int rep = 0; rep < REP3; ++rep) {
        ssd_scan_phase(states, alast, hprev, G, bx, tid);
        SEAM(3); }
    }
    if (PH(4)) {
        for (int rep = 0; rep < REP4; ++rep) {
        ssd_b_phase(lds, proj, xc, dtv, acum, hprev, args.in[7], args.in[8], states, ymix, G, bx, tid, lane, wave);
        SEAM(4); }
    }
    if (PH(5)) {
        pg8::Gemm g{ymix, WoT, M, 1024, 1024}; pg8::StaticOrder S; S.init(M, 1024, G, bx);
        pg8::EpiResid E{x, x2, x2b, ss2, M};
        pg8::gemm_phase<pg8::EpiResid, pg8::StaticOrder, false, true>(lds, g, S, E);
        SEAM(5);
    }
    if (PH(6)) {
        pg8::Gemm g{x2b, WguT, M, 2 * D_FF, 1024}; pg8::StaticOrder S; S.init(M, 2 * D_FF, G, bx);
        pg8::EpiSwiGLU E{act, D_FF, ss2, M, EPS};
        pg8::gemm_phase<pg8::EpiSwiGLU, pg8::StaticOrder, true, true>(lds, g, S, E);
        SEAM(6);
    }
    if (PH(7)) {
        pg8::Gemm g{act, WdT, M, 1024, D_FF}; pg8::StaticOrder S; S.init(M, 1024, G, bx);
        pg8::EpiResid E{x2, args.out, nullptr, ss3, M};
        pg8::gemm_phase<pg8::EpiResid, pg8::StaticOrder, false, true>(lds, g, S, E);
        SEAM(7);
    }
    if (PH(8)) {
        const int gw = bx * NWAVES + wave, NGW = G * NWAVES;
        for (int m = gw; m < M; m += NGW) {
            f32x4* xr = (f32x4*)(args.out + (size_t)m * D_MODEL) + lane;
            const float ss = (ss3[m] + ss3[M + m]) + (ss3[2 * M + m] + ss3[3 * M + m]);
            const float rs = rsqrtf(ss * (1.f / D_MODEL) + EPS);
#pragma unroll
            for (int j = 0; j < 4; ++j) { const f32x4 v = xr[64 * j]; const f32x4 w = ((const f32x4*)norm_final_w)[lane + 64 * j]; xr[64 * j] = v * rs * w; }
        }
    }
#undef PH
#undef SEAM
}

static int g_grid = 0;
static void launch_mega(const Args& a0, int phmask, hipStream_t stream) {
    Args a = a0; a.phmask = phmask;
    void* kargs[] = {&a};
    hipError_t e = hipLaunchCooperativeKernel((const void*)mega_fwd, dim3(g_grid), dim3(NWAVES * 64), kargs, LDS_BYTES, stream);
    if (e != hipSuccess) fprintf(stderr, "cooperative launch failed: %s (grid %d)\n", hipGetErrorString(e), g_grid);
}
extern "C" void kernel_launch(void* const* d_in, const int* in_sizes, int n_in, void* d_out, int out_size, void* d_ws, size_t ws_size, hipStream_t stream) {
    if (g_grid == 0) {
        int dev = 0, cus = 0, per_cu = 0;
        (void)hipGetDevice(&dev);
        (void)hipDeviceGetAttribute(&cus, hipDeviceAttributeMultiprocessorCount, dev);
        if (hipFuncSetAttribute((const void*)mega_fwd, hipFuncAttributeMaxDynamicSharedMemorySize, LDS_BYTES) != hipSuccess) fprintf(stderr, "hipFuncSetAttribute failed\n");
        if (hipOccupancyMaxActiveBlocksPerMultiprocessor(&per_cu, (const void*)mega_fwd, NWAVES * 64, LDS_BYTES) != hipSuccess || per_cu < 1) { fprintf(stderr, "occupancy query: %d\n", per_cu); per_cu = 1; }
        (void)hipGetLastError();
        g_grid = cus;
    }
    Args a{};
    for (int i = 0; i < 16; ++i) a.in[i] = (const float*)d_in[i];
    a.out = (float*)d_out; a.ws = (unsigned char*)d_ws; a.phmask = 0; a.pad = 0;
    unsigned char* ws = (unsigned char*)d_ws;
    const float* conv_w = (const float*)d_in[3]; const float* conv_b = (const float*)d_in[4]; const float* dt_bias = (const float*)d_in[5];
    const float* a_log = (const float*)d_in[6]; const float* d_skip = (const float*)d_in[7]; const float* ssm_norm_w = (const float*)d_in[8];
    const float* sinks = (const float*)d_in[9];
    bf16* proj = (bf16*)(ws + WS_PROJ); bf16* xc = (bf16*)(ws + WS_XC); float* yssd = (float*)(ws + WS_STATES); bf16* ymix = (bf16*)(ws + WS_YMIX);
    float* dtraw = (float*)(ws + WS_DTRAW);
    (void)hipMemsetAsync(d_ws, 0, 16384, stream);
    launch_mega(a, 0x1FF, stream);
}
```
